# Optimizing an MI355X kernel written in HIP

```python
import math
import jax, jax.numpy as jnp
from jax import lax
import numpy as np

D_MODEL = 2048
BATCH = 8
SEQ = 2048
DEPTH = 1

CHUNK = 64
Q_BLOCK = 128
MIX_WIDTH = D_MODEL
DIFF_HEADS = 4
DIFF_QK_DIM = 128
DIFF_V_DIM = 2 * DIFF_QK_DIM
DIFF_WIDTH = DIFF_HEADS * DIFF_V_DIM
GMLP_CHUNK = 128
GMLP_GROUPS = 8
GMLP_GROUP_DIM = 128
GMLP_WIDTH = GMLP_GROUPS * GMLP_GROUP_DIM
IN_DIM = 3 * DIFF_HEADS * 2 * DIFF_QK_DIM // 2 * 2 // 2 * 1 + 0
IN_DIM = 2 * (DIFF_HEADS * 2 * DIFF_QK_DIM) + DIFF_WIDTH + 2 * GMLP_WIDTH
NUM_BUCKETS = 32
MAX_DISTANCE = 128
FFN_HIDDEN = ((8 * D_MODEL // 3 + 255) // 256) * 256
PLE_DIM = 256
EPS = 1e-6
NEG_INF = -1e30

kernel_name = "hybrid_diffattn_gmlp_chunk_causal_block"


def rms_norm(x, g):
    x32 = x.astype(jnp.float32)
    y = x32 * lax.rsqrt(jnp.mean(x32 * x32, axis=-1, keepdims=True) + EPS)
    return (y * g.astype(jnp.float32)).astype(x.dtype)


def layer_norm(x, g, b):
    x32 = x.astype(jnp.float32)
    mu = jnp.mean(x32, axis=-1, keepdims=True)
    xc = x32 - mu
    y = xc * lax.rsqrt(jnp.mean(xc * xc, axis=-1, keepdims=True) + EPS)
    return (y * g.astype(jnp.float32) + b.astype(jnp.float32)).astype(x.dtype)


def t5_bucket(rel):
    half = NUM_BUCKETS // 2
    max_exact = half // 2
    ret = jnp.where(rel > 0, half, 0)
    n = jnp.abs(rel)
    nf = jnp.maximum(n, 1).astype(jnp.float32)
    large = max_exact + (jnp.log(nf / max_exact) / math.log(MAX_DISTANCE / max_exact)
                         * (half - max_exact)).astype(jnp.int32)
    large = jnp.minimum(large, half - 1)
    return ret + jnp.where(n < max_exact, n, large)


def diff_attention(q, k, v, lam, rel_bias):
    seq = q.shape[1]
    scale = DIFF_QK_DIM ** -0.5
    outs = []
    for blk in range(seq // Q_BLOCK):
        q0, q1 = blk * Q_BLOCK, (blk + 1) * Q_BLOCK
        qb, kb, vb = q[:, q0:q1], k[:, :q1], v[:, :q1]
        qpos = jnp.arange(q0, q1, dtype=jnp.int32)
        kpos = jnp.arange(q1, dtype=jnp.int32)
        logits = jnp.einsum('bqhmd,bkhmd->bhmqk', qb, kb).astype(jnp.float32) * scale
        bias = rel_bias[t5_bucket(kpos[None, :] - qpos[:, None])]
        bias = jnp.transpose(bias, (2, 0, 1)).astype(jnp.float32)
        mask = (kpos[None, :] // CHUNK) <= (qpos[:, None] // CHUNK)
        logits = jnp.where(mask, logits + bias[None, :, None], NEG_INF)
        probs = jax.nn.softmax(logits, axis=-1)
        attn = probs[:, :, 0] - lam * probs[:, :, 1]
        outs.append(jnp.einsum('bhqk,bkhe->bqhe', attn.astype(v.dtype), vb))
    return jnp.concatenate(outs, axis=1)


def gmlp_spatial_gate(u, vg, ln_g, ln_b, ws, bs):
    bsz, seq, _ = u.shape
    nb = seq // GMLP_CHUNK
    vn = layer_norm(vg, ln_g, ln_b).reshape(bsz, nb, GMLP_CHUNK, GMLP_GROUPS, GMLP_GROUP_DIM)
    pos = jnp.arange(GMLP_CHUNK)
    mask = (pos[None, :] // CHUNK) <= (pos[:, None] // CHUNK)
    ws_m = jnp.where(mask[None], ws, jnp.zeros_like(ws))
    s = jnp.einsum('gij,bnjgc->bnigc', ws_m, vn) + jnp.transpose(bs)[None, None, :, :, None]
    out = u.reshape(bsz, nb, GMLP_CHUNK, GMLP_GROUPS, GMLP_GROUP_DIM) * s
    return out.reshape(bsz, seq, GMLP_WIDTH)


def setup_inputs(seed: int = 0) -> dict:
    key = jax.random.key(seed)
    ks = jax.random.split(key, 24)
    f32 = jnp.float32
    nrm = lambda k, shape, s: jax.random.normal(k, shape, f32) * s
    gain = lambda k, shape: 1.0 + 0.05 * jax.random.normal(k, shape, f32)
    return {
        "x": jax.random.normal(ks[0], (BATCH, SEQ, D_MODEL), f32),
        "p": jax.random.normal(ks[1], (DEPTH, BATCH, SEQ, PLE_DIM), f32),
        "w_in": nrm(ks[2], (DEPTH, D_MODEL, IN_DIM), D_MODEL ** -0.5),
        "w_out": nrm(ks[3], (DEPTH, MIX_WIDTH, D_MODEL), MIX_WIDTH ** -0.5),
        "attn_norm_g": gain(ks[4], (DEPTH, D_MODEL)),
        "ffn_norm_g": gain(ks[5], (DEPTH, D_MODEL)),
        "final_norm_g": gain(ks[6], (D_MODEL,)),
        "lambda_q1": nrm(ks[7], (DEPTH, DIFF_QK_DIM), 0.1),
        "lambda_k1": nrm(ks[8], (DEPTH, DIFF_QK_DIM), 0.1),
        "lambda_q2": nrm(ks[9], (DEPTH, DIFF_QK_DIM), 0.1),
        "lambda_k2": nrm(ks[10], (DEPTH, DIFF_QK_DIM), 0.1),
        "subln_g": gain(ks[11], (DEPTH, DIFF_V_DIM)),
        "rel_bias": nrm(ks[12], (NUM_BUCKETS, DIFF_HEADS), 0.2),
        "gmlp_ln_g": gain(ks[13], (DEPTH, GMLP_WIDTH)),
        "gmlp_ln_b": nrm(ks[14], (DEPTH, GMLP_WIDTH), 0.02),
        "gmlp_ws": nrm(ks[15], (DEPTH, GMLP_GROUPS, GMLP_CHUNK, GMLP_CHUNK), GMLP_CHUNK ** -0.5),
        "gmlp_b": gain(ks[16], (DEPTH, GMLP_GROUPS, GMLP_CHUNK)),
        "ffn_w1": nrm(ks[17], (DEPTH, D_MODEL, FFN_HIDDEN), D_MODEL ** -0.5),
        "ffn_w3": nrm(ks[18], (DEPTH, D_MODEL, FFN_HIDDEN), D_MODEL ** -0.5),
        "ffn_w2": nrm(ks[19], (DEPTH, FFN_HIDDEN, D_MODEL), FFN_HIDDEN ** -0.5),
        "pl_w_up": nrm(ks[20], (DEPTH, PLE_DIM, D_MODEL), PLE_DIM ** -0.5),
        "pl_w_gate": nrm(ks[21], (DEPTH, D_MODEL, D_MODEL), D_MODEL ** -0.5),
    }


def reference(x, p, w_in, w_out, attn_norm_g, ffn_norm_g, final_norm_g,
              lambda_q1, lambda_k1, lambda_q2, lambda_k2, subln_g, rel_bias,
              gmlp_ln_g, gmlp_ln_b, gmlp_ws, gmlp_b, ffn_w1, ffn_w3, ffn_w2,
              pl_w_up, pl_w_gate):
    bsz, seq, _ = x.shape
    qk_cols = DIFF_HEADS * 2 * DIFF_QK_DIM
    splits = [qk_cols, 2 * qk_cols, 2 * qk_cols + DIFF_WIDTH,
              2 * qk_cols + DIFF_WIDTH + GMLP_WIDTH]
    h = x
    for i in range(DEPTH):
        a = rms_norm(h, attn_norm_g[i])
        z = a @ w_in[i]
        zq, zk, zv, zu, zg = jnp.split(z, splits, axis=-1)
        q = zq.reshape(bsz, seq, DIFF_HEADS, 2, DIFF_QK_DIM)
        k = zk.reshape(bsz, seq, DIFF_HEADS, 2, DIFF_QK_DIM)
        v = zv.reshape(bsz, seq, DIFF_HEADS, DIFF_V_DIM)
        lam_init = 0.8 - 0.6 * math.exp(-0.3 * i)
        lam = (jnp.exp(jnp.sum(lambda_q1[i].astype(jnp.float32) * lambda_k1[i].astype(jnp.float32)))
               - jnp.exp(jnp.sum(lambda_q2[i].astype(jnp.float32) * lambda_k2[i].astype(jnp.float32)))
               + lam_init)
        o_diff = diff_attention(q, k, v, lam, rel_bias)
        o_diff = rms_norm(o_diff, subln_g[i]) * (1.0 - lam_init)
        o_diff = o_diff.reshape(bsz, seq, DIFF_WIDTH)
        o_gmlp = gmlp_spatial_gate(jax.nn.gelu(zu), jax.nn.gelu(zg),
                                   gmlp_ln_g[i], gmlp_ln_b[i], gmlp_ws[i], gmlp_b[i])
        mixed = jnp.concatenate([o_diff.astype(h.dtype), o_gmlp.astype(h.dtype)], axis=-1)
        h = h + mixed @ w_out[i]
        f = rms_norm(h, ffn_norm_g[i])
        h = h + (jax.nn.silu(f @ ffn_w1[i]) * (f @ ffn_w3[i])) @ ffn_w2[i]
        h = h + (p[i] @ pl_w_up[i]) * jax.nn.sigmoid(h @ pl_w_gate[i])
    return rms_norm(h, final_norm_g)
```

```cpp
#define MK_N_LAUNCHES 1
#include <hip/hip_runtime.h>
#include <cstdio>
#include <cstdint>
#include <cmath>
namespace pg8 {
#define PG8_LAS __attribute__((address_space(3)))
typedef unsigned short bf16_t;
typedef short bf16x8 __attribute__((ext_vector_type(8)));
typedef float f32x4 __attribute__((ext_vector_type(4)));
typedef unsigned u32x4 __attribute__((ext_vector_type(4)));
constexpr int BM = 256, BK = 64, HALF = 128, HTB = HALF * BK * 2  , STAGE_BYTES = 8 * HTB, NXCD = 8, WGM = 8;

__host__ __device__ __forceinline__ int lds_byte(int r, int c) { const int st = (r >> 4) * 2 + (c >> 5), rr = r & 15, cc = c & 31, ob = rr * 64 + cc * 2; return st * 1024 + (ob ^ (((ob >> 9) & 1) << 5)); }
__host__ __device__ __forceinline__ void stage_rc(int b, int& R, int& C) { const int st = b / 1024, sb = b % 1024, swz = sb ^ (((sb >> 9) & 1) << 5); R = (st >> 1) * 16 + swz / 64; C = (st & 1) * 32 + (swz % 64) / 2; }
__host__ __device__ __forceinline__ int perm32(int rho) { const int n = rho >> 4, i = rho & 15; return 8 * (i >> 2) + 4 * n + (i & 3); }

struct Unit { int pm, pn; };
struct Gemm { const bf16_t* A; const bf16_t* Bt; int M, N, K; };

struct StaticOrder {
    int nM, nN, nwg, G, c;
    __host__ __device__ void init(int M, int N, int G_, int c_) { nM = M / BM; nN = N / BM; nwg = nM * nN; G = G_; c = c_; }
    __host__ __device__ bool next(int i, Unit& u) const {
        const long L = (long)i * G + c; if (L >= nwg) return false;
        int wgid = (int)L; { const int q = nwg / NXCD, r = nwg % NXCD, xcd = wgid % NXCD, off = wgid / NXCD; wgid = (xcd < r ? xcd * (q + 1) : r * (q + 1) + (xcd - r) * q) + off; }
        const int nig = WGM * nN, gid = wgid / nig, fm = gid * WGM, gsz = (nM - fm) < WGM ? (nM - fm) : WGM;
        u.pm = fm + ((wgid % nig) % gsz); u.pn = (wgid % nig) / gsz; return true;
    }
    __device__ __forceinline__ void a_ready(const Unit&) const {}
    __device__ __forceinline__ void done(const Unit&) const {}
};
__device__ __forceinline__ unsigned cvt_pk_bf16(float lo, float hi) { unsigned r; asm volatile("v_cvt_pk_bf16_f32 %0, %1, %2" : "=v"(r) : "v"(lo), "v"(hi)); return r; }
typedef float f32x2 __attribute__((ext_vector_type(2)));
typedef unsigned u32x2 __attribute__((ext_vector_type(2)));
constexpr int MROWS = 16384;
__device__ __forceinline__ float gelu_tanh(float x) {
    const float u = x * (1.0f + 0.044715f * x * x);
    const float e = __builtin_amdgcn_exp2f(-2.3022082f * u);
    return x * __builtin_amdgcn_rcpf(1.0f + e);
}
__device__ __forceinline__ float sigmoid_f(float a) { return __builtin_amdgcn_rcpf(1.0f + __builtin_amdgcn_exp2f(-1.4426950409f * a)); }

struct EpiIn {
    static constexpr bool PERM = true, AFTER_DRAIN = false;
    bf16_t* O; float* lnstat; float qscale;
    __device__ __forceinline__ void operator()(const f32x4 (&acc)[2][2][4][2], const Unit& u, int wr, int wc, int fr, int fq) const {
        const int t = u.pn >> 2;
        bf16_t* base = O + (size_t)t * ((size_t)MROWS * 1024);
        const int row0 = u.pm * BM + wr * 64 + fr, col0 = (u.pn & 3) * 256 + wc * 32 + 8 * fq;
        const float sc = (t == 0) ? qscale : 1.0f;
#pragma unroll
        for (int ai = 0; ai < 2; ++ai)
#pragma unroll
            for (int m = 0; m < 4; ++m) {
                const int row = row0 + ai * HALF + m * 16;
                bf16_t* rowp = base + (size_t)row * 1024 + col0;
                float s1 = 0.f, s2 = 0.f;
#pragma unroll
                for (int bj = 0; bj < 2; ++bj) {
                    f32x4 v0 = acc[ai][bj][m][0], v1 = acc[ai][bj][m][1];
                    if (t >= 3) {
#pragma unroll
                        for (int e = 0; e < 4; ++e) { v0[e] = gelu_tanh(v0[e]); v1[e] = gelu_tanh(v1[e]); }
                    } else { v0 = v0 * sc; v1 = v1 * sc; }
                    if (t == 4) {
                        s1 += (v0[0] + v0[1]) + (v0[2] + v0[3]) + (v1[0] + v1[1]) + (v1[2] + v1[3]);
                        s2 += (v0[0] * v0[0] + v0[1] * v0[1]) + (v0[2] * v0[2] + v0[3] * v0[3]) + (v1[0] * v1[0] + v1[1] * v1[1]) + (v1[2] * v1[2] + v1[3] * v1[3]);
                    }
                    u32x4 w; w.x = cvt_pk_bf16(v0[0], v0[1]); w.y = cvt_pk_bf16(v0[2], v0[3]); w.z = cvt_pk_bf16(v1[0], v1[1]); w.w = cvt_pk_bf16(v1[2], v1[3]);
                    *(u32x4*)(rowp + bj * HALF) = w;
                }
                if (t == 4) {
                    s1 += __shfl_xor(s1, 16); s1 += __shfl_xor(s1, 32); s2 += __shfl_xor(s2, 16); s2 += __shfl_xor(s2, 32);
                    if (fq == 0) { atomicAdd(lnstat + 2 * row, s1); atomicAdd(lnstat + 2 * row + 1, s2); }
                }
            }
    }
};
struct EpiPlain {
    static constexpr bool PERM = true, AFTER_DRAIN = false;
    bf16_t* O; int ldc;
    __device__ __forceinline__ void operator()(const f32x4 (&acc)[2][2][4][2], const Unit& u, int wr, int wc, int fr, int fq) const {
        const int row0 = u.pm * BM + wr * 64 + fr, col0 = u.pn * BM + wc * 32 + 8 * fq;
#pragma unroll
        for (int ai = 0; ai < 2; ++ai)
#pragma unroll
            for (int m = 0; m < 4; ++m) {
                bf16_t* rowp = O + (size_t)(row0 + ai * HALF + m * 16) * ldc + col0;
#pragma unroll
                for (int bj = 0; bj < 2; ++bj) {
                    const f32x4 v0 = acc[ai][bj][m][0], v1 = acc[ai][bj][m][1];
                    u32x4 w; w.x = cvt_pk_bf16(v0[0], v0[1]); w.y = cvt_pk_bf16(v0[2], v0[3]); w.z = cvt_pk_bf16(v1[0], v1[1]); w.w = cvt_pk_bf16(v1[2], v1[3]);
                    *(u32x4*)(rowp + bj * HALF) = w;
                }
            }
    }
};
struct EpiResid {
    static constexpr bool PERM = false, AFTER_DRAIN = false;
    const float* base; float* out; bf16_t* ob; float* ss; int ldc;
    __device__ __forceinline__ void operator()(const f32x4 (&acc)[2][2][4][2], const Unit& u, int wr, int wc, int fr, int fq) const {
        const int row0 = u.pm * BM + wr * 64 + fr, col0 = u.pn * BM + wc * 32 + 4 * fq;
#pragma unroll
        for (int ai = 0; ai < 2; ++ai)
#pragma unroll
            for (int m = 0; m < 4; ++m) {
                const int row = row0 + ai * HALF + m * 16; const size_t off = (size_t)row * ldc + col0; float s = 0.f;
#pragma unroll
                for (int bj = 0; bj < 2; ++bj)
#pragma unroll
                    for (int n = 0; n < 2; ++n) {
                        const f32x4 bs = *(const f32x4*)(base + off + bj * HALF + n * 16);
                        const f32x4 o = bs + acc[ai][bj][m][n];
                        *(f32x4*)(out + off + bj * HALF + n * 16) = o;
                        u32x2 w; w.x = cvt_pk_bf16(o[0], o[1]); w.y = cvt_pk_bf16(o[2], o[3]);
                        *(u32x2*)(ob + off + bj * HALF + n * 16) = w;
                        s += (o[0] * o[0] + o[1] * o[1]) + (o[2] * o[2] + o[3] * o[3]);
                    }
                if (ss) { s += __shfl_xor(s, 16); s += __shfl_xor(s, 32); if (fq == 0) atomicAdd(ss + row, s); }
            }
    }
};
struct EpiSwiGLU {
    static constexpr bool PERM = true, AFTER_DRAIN = false;
    bf16_t* O; const float* ss; int ldc;
    __device__ __forceinline__ void operator()(const f32x4 (&acc)[2][2][4][2], const Unit& u, int wr, int wc, int fr, int fq) const {
        const int row0 = u.pm * BM + wr * 64 + fr, col0 = u.pn * HALF + wc * 32 + 8 * fq;
#pragma unroll
        for (int ai = 0; ai < 2; ++ai)
#pragma unroll
            for (int m = 0; m < 4; ++m) {
                const int row = row0 + ai * HALF + m * 16;
                const float r = __builtin_amdgcn_rsqf(ss[row] * (1.0f / 2048.0f) + 1e-6f);
                float hv[8];
#pragma unroll
                for (int n = 0; n < 2; ++n)
#pragma unroll
                    for (int e = 0; e < 4; ++e) { const float a = r * acc[ai][0][m][n][e], b = r * acc[ai][1][m][n][e]; hv[4 * n + e] = a * sigmoid_f(a) * b; }
                u32x4 w; w.x = cvt_pk_bf16(hv[0], hv[1]); w.y = cvt_pk_bf16(hv[2], hv[3]); w.z = cvt_pk_bf16(hv[4], hv[5]); w.w = cvt_pk_bf16(hv[6], hv[7]);
                *(u32x4*)(O + (size_t)row * ldc + col0) = w;
            }
    }
};
struct EpiGate {
    static constexpr bool PERM = false, AFTER_DRAIN = false;
    const float* base; float* out; const bf16_t* up; float* ss; int ldc;
    __device__ __forceinline__ void operator()(const f32x4 (&acc)[2][2][4][2], const Unit& u, int wr, int wc, int fr, int fq) const {
        const int row0 = u.pm * BM + wr * 64 + fr, col0 = u.pn * BM + wc * 32 + 4 * fq;
#pragma unroll
        for (int ai = 0; ai < 2; ++ai)
#pragma unroll
            for (int m = 0; m < 4; ++m) {
                const int row = row0 + ai * HALF + m * 16; const size_t off = (size_t)row * ldc + col0; float s = 0.f;
#pragma unroll
                for (int bj = 0; bj < 2; ++bj)
#pragma unroll
                    for (int n = 0; n < 2; ++n) {
                        const f32x4 bs = *(const f32x4*)(base + off + bj * HALF + n * 16);
                        const u32x2 uw = *(const u32x2*)(up + off + bj * HALF + n * 16);
                        const f32x4 a = acc[ai][bj][m][n];
                        f32x4 o;
                        o[0] = bs[0] + __uint_as_float(uw.x << 16) * sigmoid_f(a[0]);
                        o[1] = bs[1] + __uint_as_float(uw.x & 0xffff0000u) * sigmoid_f(a[1]);
                        o[2] = bs[2] + __uint_as_float(uw.y << 16) * sigmoid_f(a[2]);
                        o[3] = bs[3] + __uint_as_float(uw.y & 0xffff0000u) * sigmoid_f(a[3]);
                        *(f32x4*)(out + off + bj * HALF + n * 16) = o;
                        s += (o[0] * o[0] + o[1] * o[1]) + (o[2] * o[2] + o[3] * o[3]);
                    }
                s += __shfl_xor(s, 16); s += __shfl_xor(s, 32); if (fq == 0) atomicAdd(ss + row, s);
            }
    }
};

template <class Epi, class Sched, bool ALIGN_EPI = false, bool SP2 = false>
__device__ __forceinline__ void gemm_phase(PG8_LAS unsigned char* lds, const Gemm g, const Sched& S, const Epi& E) {
    const int tid = threadIdx.x, wid = __builtin_amdgcn_readfirstlane(tid >> 6), lane = tid & 63, wr = wid >> 2, wc = wid & 3, fr = lane & 15, fq = lane >> 4;
    const int K = g.K, nt = K / BK;
    unsigned voffA[2], voffB[2];
#pragma unroll
    for (int i = 0; i < 2; ++i) { int R, C; stage_rc(tid * 16 + i * 8192, R, C); const int Rb = Epi::PERM ? ((R & ~31) + perm32(R & 31)) : R;
        voffA[i] = (unsigned)(R * K + C) * 2u; voffB[i] = (unsigned)(Rb * K + C) * 2u; }
    const size_t kstep = (size_t)(BK * 2);
    const size_t hstep = (size_t)HALF * K * 2;
    const size_t tstep = 2 * hstep;
    const unsigned ldsw = (unsigned)wid * 1024u;
    const int aoff = lds_byte(wr * 64 + fr, fq * 8), boff = lds_byte(wc * 32 + fr, fq * 8);
#define PG8_SA(b, h) (((b) * 2 + (h)) * HTB)
#define PG8_SB(b, h) ((4 + (b) * 2 + (h)) * HTB)
#define PG8_STAGE(bufoff, gbase, voff) do { _Pragma("unroll") for (int _i = 0; _i < 2; ++_i) \
        __builtin_amdgcn_global_load_lds((const unsigned*)((const char*)(gbase) + (voff)[_i]), (PG8_LAS unsigned*)(lds + (bufoff) + ldsw + _i * 8192), 16, 0, 0); } while (0)
#define PG8_LDA(dst, b, h) do { _Pragma("unroll") for (int m = 0; m < 4; ++m) _Pragma("unroll") for (int k = 0; k < 2; ++k) dst[m][k] = *(const PG8_LAS bf16x8*)(lds + PG8_SA(b, h) + aoff + m * 2048 + k * 1024); } while (0)
#define PG8_LDB(dst, b, h) do { _Pragma("unroll") for (int n = 0; n < 2; ++n) _Pragma("unroll") for (int k = 0; k < 2; ++k) dst[n][k] = *(const PG8_LAS bf16x8*)(lds + PG8_SB(b, h) + boff + n * 2048 + k * 1024); } while (0)
#define PG8_MMA(ai, bj, At, Bt) do { __builtin_amdgcn_s_setprio(1); _Pragma("unroll") for (int m = 0; m < 4; ++m) _Pragma("unroll") for (int n = 0; n < 2; ++n) _Pragma("unroll") for (int k = 0; k < 2; ++k) \
        acc[ai][bj][m][n] = __builtin_amdgcn_mfma_f32_16x16x32_bf16(Bt[n][k], At[m][k], acc[ai][bj][m][n], 0, 0, 0); __builtin_amdgcn_s_setprio(0); } while (0)
#define PG8_WAIT_V(n) asm volatile("s_waitcnt vmcnt(" #n ")" ::: "memory")
#define PG8_WAIT_L(n) asm volatile("s_waitcnt lgkmcnt(" #n ")" ::: "memory")
#define PG8_BAR __builtin_amdgcn_s_barrier()
#define PG8_SCHED __builtin_amdgcn_sched_barrier(0)
    Unit cur, nxt; int ui = 0;
    if (!S.next(0, cur)) return;
    f32x4 acc[2][2][4][2];
#pragma unroll
    for (int a = 0; a < 2; ++a)
#pragma unroll
        for (int b = 0; b < 2; ++b)
#pragma unroll
            for (int m = 0; m < 4; ++m)
#pragma unroll
                for (int n = 0; n < 2; ++n) acc[a][b][m][n] = (f32x4){0.f, 0.f, 0.f, 0.f};
    bf16x8 At[4][2], B0[2][2], B1[2][2];
    const char* cA = (const char*)g.A + (size_t)cur.pm * tstep; const char* cB = (const char*)g.Bt + (size_t)cur.pn * tstep;
    S.a_ready(cur);
    if constexpr (SP2) {
        PG8_STAGE(PG8_SB(0, 0), cB, voffB); PG8_STAGE(PG8_SB(0, 1), cB + hstep, voffB); PG8_STAGE(PG8_SA(0, 0), cA, voffA); PG8_STAGE(PG8_SA(0, 1), cA + hstep, voffA);
        if (wr == 1) PG8_BAR;
        PG8_WAIT_V(2); PG8_BAR;
        PG8_STAGE(PG8_SB(1, 0), cB + kstep, voffB); PG8_STAGE(PG8_SA(1, 0), cA + kstep, voffA); PG8_STAGE(PG8_SB(1, 1), cB + hstep + kstep, voffB);
        PG8_WAIT_V(6); PG8_BAR;
    } else {
        PG8_STAGE(PG8_SB(0, 0), cB, voffB); PG8_STAGE(PG8_SA(0, 0), cA, voffA); PG8_STAGE(PG8_SB(0, 1), cB + hstep, voffB); PG8_STAGE(PG8_SA(0, 1), cA + hstep, voffA);
        if (wr == 1) PG8_BAR;
        PG8_WAIT_V(4); PG8_BAR;
        PG8_STAGE(PG8_SB(1, 0), cB + kstep, voffB); PG8_STAGE(PG8_SA(1, 0), cA + kstep, voffA); PG8_STAGE(PG8_SB(1, 1), cB + hstep + kstep, voffB);
        PG8_WAIT_V(6); PG8_BAR;
    }
    for (;;) {
        const bool has_next = S.next(ui + 1, nxt);
        const char* nA = has_next ? (const char*)g.A + (size_t)nxt.pm * tstep : cA; const char* nB = has_next ? (const char*)g.Bt + (size_t)nxt.pn * tstep : cB;
        for (int t = 0; t < nt; t += 2) {
            const bool last = (t == nt - 2);
            const char* a1 = cA + (size_t)(t + 1) * kstep;
            const char* a2 = last ? nA : cA + (size_t)(t + 2) * kstep; const char* b2 = last ? nB : cB + (size_t)(t + 2) * kstep;
            const char* a3 = a2 + kstep; const char* b3 = b2 + kstep;
            if (last && has_next) S.a_ready(nxt);
            if constexpr (SP2) {
            PG8_LDB(B0, 0, 0); PG8_LDB(B1, 0, 1); PG8_SCHED; PG8_LDA(At, 0, 0); PG8_STAGE(PG8_SA(1, 1), a1 + hstep, voffA);
            PG8_WAIT_V(8); PG8_WAIT_L(0); PG8_BAR; PG8_MMA(0, 0, At, B0); PG8_MMA(0, 1, At, B1); PG8_BAR; PG8_SCHED;
            PG8_LDA(At, 0, 1); PG8_STAGE(PG8_SB(0, 0), b2, voffB); PG8_STAGE(PG8_SB(0, 1), b2 + hstep, voffB); PG8_STAGE(PG8_SA(0, 0), a2, voffA);
            PG8_WAIT_V(8); PG8_WAIT_L(0); PG8_BAR; PG8_MMA(1, 0, At, B0); PG8_MMA(1, 1, At, B1); PG8_BAR; PG8_SCHED;
            PG8_LDB(B0, 1, 0); PG8_LDB(B1, 1, 1); PG8_SCHED; PG8_LDA(At, 1, 0); PG8_STAGE(PG8_SA(0, 1), a2 + hstep, voffA);
            PG8_WAIT_V(8); PG8_WAIT_L(0); PG8_BAR; PG8_MMA(0, 0, At, B0); PG8_MMA(0, 1, At, B1); PG8_BAR; PG8_SCHED;
            PG8_LDA(At, 1, 1); PG8_STAGE(PG8_SB(1, 0), b3, voffB); PG8_STAGE(PG8_SB(1, 1), b3 + hstep, voffB); PG8_STAGE(PG8_SA(1, 0), a3, voffA);
            PG8_WAIT_V(8); PG8_WAIT_L(0); PG8_BAR; PG8_MMA(1, 0, At, B0); PG8_MMA(1, 1, At, B1); PG8_BAR; PG8_SCHED;
            } else {
            PG8_LDB(B0, 0, 0); PG8_SCHED; PG8_LDA(At, 0, 0); PG8_STAGE(PG8_SA(1, 1), a1 + hstep, voffA);
            PG8_WAIT_L(8); PG8_BAR; PG8_WAIT_L(0); PG8_MMA(0, 0, At, B0); PG8_BAR; PG8_SCHED;
            PG8_LDB(B1, 0, 1); PG8_STAGE(PG8_SB(0, 0), b2, voffB);
            PG8_BAR; PG8_WAIT_L(0); PG8_MMA(0, 1, At, B1); PG8_BAR;
            PG8_LDA(At, 0, 1); PG8_STAGE(PG8_SA(0, 0), a2, voffA);
            PG8_BAR; PG8_WAIT_L(0); PG8_MMA(1, 0, At, B0); PG8_BAR; PG8_SCHED;
            PG8_STAGE(PG8_SB(0, 1), b2 + hstep, voffB);
            PG8_WAIT_V(6); PG8_BAR; PG8_MMA(1, 1, At, B1); PG8_BAR;
            PG8_LDB(B0, 1, 0); PG8_SCHED; PG8_LDA(At, 1, 0); PG8_STAGE(PG8_SA(0, 1), a2 + hstep, voffA);
            PG8_WAIT_L(8); PG8_BAR; PG8_WAIT_L(0); PG8_MMA(0, 0, At, B0); PG8_BAR; PG8_SCHED;
            PG8_LDB(B1, 1, 1); PG8_STAGE(PG8_SB(1, 0), b3, voffB);
            PG8_BAR; PG8_WAIT_L(0); PG8_MMA(0, 1, At, B1); PG8_BAR;
            PG8_LDA(At, 1, 1); PG8_STAGE(PG8_SA(1, 0), a3, voffA);
            PG8_BAR; PG8_WAIT_L(0); PG8_MMA(1, 0, At, B0); PG8_BAR; PG8_SCHED;
            PG8_STAGE(PG8_SB(1, 1), b3 + hstep, voffB);
            PG8_WAIT_V(6); PG8_BAR; PG8_MMA(1, 1, At, B1); PG8_BAR;
            }
        }
        if constexpr (ALIGN_EPI) { if (wr == 0) PG8_BAR; }
        if constexpr (!Epi::AFTER_DRAIN) { E(acc, cur, wr, wc, fr, fq); S.done(cur); }
        if (!has_next) break;
#pragma unroll
        for (int a = 0; a < 2; ++a)
#pragma unroll
            for (int b = 0; b < 2; ++b)
#pragma unroll
                for (int m = 0; m < 4; ++m)
#pragma unroll
                    for (int n = 0; n < 2; ++n) acc[a][b][m][n] = (f32x4){0.f, 0.f, 0.f, 0.f};
        cur = nxt; cA = nA; cB = nB; ++ui;
        if constexpr (ALIGN_EPI) { if (wr == 1) PG8_BAR; }
    }
    PG8_WAIT_V(0);
    if constexpr (!ALIGN_EPI) { if (wr == 0) PG8_BAR; }
    PG8_BAR;
    if constexpr (Epi::AFTER_DRAIN) { E.fused(acc, cur, wr, wc, fr, fq, lds, wid, lane); S.done(cur); }
#undef PG8_SA
#undef PG8_SB
#undef PG8_STAGE
#undef PG8_LDA
#undef PG8_LDB
#undef PG8_MMA
#undef PG8_WAIT_V
#undef PG8_WAIT_L
#undef PG8_BAR
#undef PG8_SCHED
}
}
#define GAS __attribute__((address_space(1)))
#define LAS __attribute__((address_space(3)))
typedef unsigned short bf16;
typedef unsigned v4u __attribute__((ext_vector_type(4)));
typedef float f32x4 __attribute__((ext_vector_type(4)));
typedef short bf16x8 __attribute__((ext_vector_type(8)));
typedef GAS unsigned gu32;
typedef GAS unsigned long long gu64;
#define RLX_AGENT __ATOMIC_RELAXED, __HIP_MEMORY_SCOPE_AGENT
#define LDS_WAIT() asm volatile("s_waitcnt lgkmcnt(0)" ::: "memory")
#define VM_WAIT() asm volatile("s_waitcnt vmcnt(0)" ::: "memory")
__device__ __forceinline__ unsigned long long rt() { return __builtin_amdgcn_s_memrealtime(); }
__device__ __forceinline__ unsigned f2bf(float f) { unsigned u = __builtin_bit_cast(unsigned, f); return (u + 0x7fffu + ((u >> 16) & 1u)) >> 16; }
__device__ __forceinline__ unsigned pk2(float lo, float hi) { return f2bf(lo) | (f2bf(hi) << 16); }
#define XB_TMO      128
#define XB_XCNT(j)  (256  + 64 * (j))
#define XB_XSUB(j)  (1280 + 64 * (j))
#define XB_XGEN(j)  (2304 + 64 * (j))
#define XB_TOP      3328
#define XB_TOPGEN   3392
#define XCD_BAR_WORDS 3456
#define XB_SPIN_CAP (1u << 18)

__device__ __forceinline__ unsigned xb_ld(unsigned* p)              { return __hip_atomic_load(p, __ATOMIC_RELAXED, __HIP_MEMORY_SCOPE_AGENT); }
__device__ __forceinline__ unsigned xb_add(unsigned* p, unsigned v) { return __hip_atomic_fetch_add(p, v, __ATOMIC_RELAXED, __HIP_MEMORY_SCOPE_AGENT); }
__device__ __forceinline__ unsigned xb_xcc_id() { return (unsigned)__builtin_amdgcn_s_getreg((3 << 11) | 20) & 0xFu; }
#define XB_SPIN(cond, bar) do { unsigned _sp = 0; while (cond) { __builtin_amdgcn_s_sleep(1); \
    if ((++_sp & 255u) == 0u) { if (xb_ld(&(bar)[XB_TMO])) break; if (_sp > XB_SPIN_CAP) { atomicAdd(&(bar)[XB_TMO], 1u); break; } } } } while (0)

struct XcdBarrier {
    unsigned* bar; unsigned x;
    volatile LAS unsigned* st;
};

__device__ __forceinline__ XcdBarrier xcd_barrier_post(unsigned* bar, volatile LAS unsigned* st) {
    XcdBarrier b; b.bar = bar; b.x = xb_xcc_id(); b.st = st;
    if (threadIdx.x == 0) (void)xb_add(&bar[XB_XCNT(b.x)], 1u);
    return b;
}
__device__ __forceinline__ void xcd_barrier_complete(unsigned* bar, unsigned x, unsigned& nloc, unsigned& nx) {
    const unsigned G = gridDim.x * gridDim.y * gridDim.z;
    unsigned sum, cnt, mine, sp = 0u;
    for (;;) {
        sum = 0u; cnt = 0u; mine = 0u;
#pragma unroll
        for (unsigned j = 0; j < 16; ++j) { const unsigned c = xb_ld(&bar[XB_XCNT(j)]); sum += c; cnt += (c > 0u) ? 1u : 0u; mine = (j == x) ? c : mine; }
        if (sum == G) break;
        __builtin_amdgcn_s_sleep(1);
        if ((++sp & 255u) == 0u) { if (xb_ld(&bar[XB_TMO])) break; if (sp > XB_SPIN_CAP) { atomicAdd(&bar[XB_TMO], 1u); break; } }
    }
    nloc = mine > 0u ? mine : 1u; nx = cnt > 0u ? cnt : 1u;
}

__device__ __forceinline__ void xcd_barrier(const XcdBarrier& b) {
    asm volatile("s_waitcnt vmcnt(0)" ::: "memory");
    __syncthreads();
    if (threadIdx.x == 0) {
        unsigned* bar = b.bar;
        __builtin_amdgcn_s_waitcnt(0);
        unsigned nloc = b.st[0], nx = b.st[1];
        if (nloc == 0u) { xcd_barrier_complete(bar, b.x, nloc, nx); b.st[0] = nloc; b.st[1] = nx; }
        const unsigned old = xb_add(&bar[XB_XSUB(b.x)], 1u);
        const unsigned gen = old / nloc;
        if (old + 1u == (gen + 1u) * nloc) {
            __builtin_amdgcn_fence(__ATOMIC_RELEASE, "agent");
            asm volatile("s_waitcnt vmcnt(0)" ::: "memory");
            const unsigned og = xb_add(&bar[XB_TOP], 1u);
            const unsigned tg = og / nx;
            if (og + 1u == (tg + 1u) * nx) xb_add(&bar[XB_TOPGEN], 1u);
            else XB_SPIN(xb_ld(&bar[XB_TOPGEN]) == tg, bar);
            __builtin_amdgcn_fence(__ATOMIC_ACQUIRE, "agent");
            xb_add(&bar[XB_XGEN(b.x)], 1u);
            asm volatile("s_waitcnt vmcnt(0)" ::: "memory");
        } else {
            XB_SPIN(xb_ld(&bar[XB_XGEN(b.x)]) == gen, bar);
            __builtin_amdgcn_fence(__ATOMIC_ACQUIRE, "agent");
            asm volatile("s_waitcnt vmcnt(0)" ::: "memory");
        }
    }
    __syncthreads();
}
constexpr int NWAVES = 8;
constexpr int BATCH = 8, SEQ = 2048, DM = 2048, M = BATCH * SEQ;
constexpr int IN_DIM = 5120, FF = 5632, PLE = 256, NH = 4, GW = 1024;
constexpr float EPS = 1e-6f, LOG2E = 1.4426950408889634f;
constexpr float QSCALE = 0.08838834764831845f * LOG2E;
typedef unsigned short bf16_t;
typedef unsigned u32x2 __attribute__((ext_vector_type(2)));
typedef unsigned u32x4v __attribute__((ext_vector_type(4)));
typedef short v4i16_t __attribute__((ext_vector_type(4)));
typedef LAS unsigned char* lptr;

constexpr size_t MiB = 1u << 20;
constexpr size_t WS_CTL = 0, CTL_ZERO_BYTES = 2 * MiB;
constexpr size_t WS_LNSTAT = 1 * MiB, WS_SS1 = 1 * MiB + 128 * 1024, WS_SS3 = 1 * MiB + 192 * 1024;
constexpr size_t WS_WIN = 2 * MiB, WS_WOUT = 22 * MiB, WS_W13 = 30 * MiB, WS_W2 = 74 * MiB, WS_WG = 96 * MiB, WS_WUP = 104 * MiB, WS_WSM = 105 * MiB;
constexpr size_t WS_PB = 106 * MiB;
constexpr size_t WS_UP = 114 * MiB;
constexpr size_t WS_A0 = 178 * MiB;
constexpr size_t WS_QKVUG = 242 * MiB;
constexpr size_t WS_H1B = 242 * MiB;
constexpr size_t WS_HID = 306 * MiB;
constexpr size_t WS_END = 482 * MiB;
constexpr int CW_BAR = 4096;

constexpr int RING_OFF = 0, RING_BYTES = 131072;
constexpr int LDSCTL_OFF = RING_BYTES, MISC_OFF = LDSCTL_OFF + 320;
constexpr int LDS_BYTES = 147456;

__device__ __forceinline__ float wave_sum(float v) {
#pragma unroll
    for (int o = 1; o < 64; o <<= 1) v += __shfl_xor(v, o);
    return v;
}
__device__ __forceinline__ float bf_lo(unsigned w) { return __uint_as_float(w << 16); }
__device__ __forceinline__ float bf_hi(unsigned w) { return __uint_as_float(w & 0xffff0000u); }

template <int MODE>
__device__ __forceinline__ void p0_transpose_item(const float* W, int K, int N, bf16_t* WT, int row_off, const float* kscale, LAS float* scr, int item, int lane) {
    const int nblk = N / 32, kb = item / nblk, nb = item % nblk, k0 = 64 * kb, n0 = 32 * nb;
#pragma unroll 8
    for (int i = 0; i < 32; ++i) { const int kk = 2 * i + (lane >> 5); float v = W[(size_t)(k0 + kk) * N + n0 + (lane & 31)]; if (kscale) v *= kscale[k0 + kk]; scr[kk * 33 + (lane & 31)] = v; }
    LDS_WAIT(); asm volatile("" ::: "memory");
    const int c = lane & 7;
#pragma unroll
    for (int j = 0; j < 4; ++j) { const int n = (lane >> 3) + 8 * j; const LAS float* s = scr + (8 * c) * 33 + n;
        v4u o; o.x = pk2(s[0 * 33], s[1 * 33]); o.y = pk2(s[2 * 33], s[3 * 33]); o.z = pk2(s[4 * 33], s[5 * 33]); o.w = pk2(s[6 * 33], s[7 * 33]);
        const int nn = n0 + n; const int row = (MODE == 0) ? nn : (256 * (nn >> 7) + (nn & 127) + row_off);
        *(GAS v4u*)(WT + (size_t)row * K + k0 + 8 * c) = o; }
    LDS_WAIT(); asm volatile("" ::: "memory");
}
struct P0Args { const float *x, *p, *w_in, *w_out, *g_attn, *g_ffn, *gmlp_ws, *w1, *w3, *w2, *w_up, *w_gate; unsigned char* ws; };
__device__ __forceinline__ void p0_prologue(const P0Args& A, lptr lds, int vcu, int G, int wave, int lane) {
    LAS float* scr = (LAS float*)(lds + RING_OFF + wave * 16384);
    const int gw = vcu * NWAVES + wave, NGW = G * NWAVES;
    bf16_t* Win_t = (bf16_t*)(A.ws + WS_WIN); bf16_t* Wout_t = (bf16_t*)(A.ws + WS_WOUT); bf16_t* W13_t = (bf16_t*)(A.ws + WS_W13); bf16_t* W2_t = (bf16_t*)(A.ws + WS_W2);
    bf16_t* Wg_t = (bf16_t*)(A.ws + WS_WG); bf16_t* Wup_t = (bf16_t*)(A.ws + WS_WUP); bf16_t* Wsm = (bf16_t*)(A.ws + WS_WSM);
    constexpr int I_IN = (DM / 64) * (IN_DIM / 32), I_OUT = (DM / 64) * (DM / 32), I_13 = (DM / 64) * (FF / 32), I_2 = (FF / 64) * (DM / 32), I_G = I_OUT, I_UP = (PLE / 64) * (DM / 32);
    constexpr int NITEMS = I_IN + I_OUT + 2 * I_13 + I_2 + I_G + I_UP;
    for (int it = gw; it < NITEMS; it += NGW) {
        int r = it;
        if (r < I_IN) { p0_transpose_item<0>(A.w_in, DM, IN_DIM, Win_t, 0, nullptr, scr, r, lane); continue; } r -= I_IN;
        if (r < I_OUT) { p0_transpose_item<0>(A.w_out, DM, DM, Wout_t, 0, nullptr, scr, r, lane); continue; } r -= I_OUT;
        if (r < I_13) { p0_transpose_item<1>(A.w1, DM, FF, W13_t, 0, A.g_ffn, scr, r, lane); continue; } r -= I_13;
        if (r < I_13) { p0_transpose_item<1>(A.w3, DM, FF, W13_t, 128, A.g_ffn, scr, r, lane); continue; } r -= I_13;
        if (r < I_2) { p0_transpose_item<0>(A.w2, FF, DM, W2_t, 0, nullptr, scr, r, lane); continue; } r -= I_2;
        if (r < I_G) { p0_transpose_item<0>(A.w_gate, DM, DM, Wg_t, 0, nullptr, scr, r, lane); continue; } r -= I_G;
        p0_transpose_item<0>(A.w_up, PLE, DM, Wup_t, 0, nullptr, scr, r, lane);
    }
    bf16_t* A0 = (bf16_t*)(A.ws + WS_A0);
    for (int m = gw; m < M; m += NGW) {
        const GAS f32x4* xr = (const GAS f32x4*)(A.x + (size_t)m * DM) + lane;
        f32x4 v[8]; float s = 0.f;
#pragma unroll
        for (int j = 0; j < 8; ++j) { v[j] = xr[64 * j]; s += (v[j].x * v[j].x + v[j].y * v[j].y) + (v[j].z * v[j].z + v[j].w * v[j].w); }
        const float r = 1.0f / sqrtf(wave_sum(s) * (1.0f / DM) + EPS);
        GAS unsigned long long* o8 = (GAS unsigned long long*)(A0 + (size_t)m * DM) + lane;
#pragma unroll
        for (int j = 0; j < 8; ++j) { const f32x4 g = *((const GAS f32x4*)A.g_attn + lane + 64 * j);
            o8[64 * j] = (unsigned long long)pk2(v[j].x * r * g.x, v[j].y * r * g.y) | ((unsigned long long)pk2(v[j].z * r * g.z, v[j].w * r * g.w) << 32); }
    }
    { bf16_t* PB = (bf16_t*)(A.ws + WS_PB); const int gt = gw * 64 + lane, NT = NGW * 64;
      for (int i = gt; i < M * PLE / 4; i += NT) { const f32x4 v = *((const GAS f32x4*)A.p + i);
          *((GAS unsigned long long*)PB + i) = (unsigned long long)pk2(v.x, v.y) | ((unsigned long long)pk2(v.z, v.w) << 32); } }
    { const int gt = gw * 64 + lane, NT = NGW * 64;
      for (int i = gt; i < 8 * 128 * 128 / 4; i += NT) { const f32x4 v = *((const GAS f32x4*)A.gmlp_ws + i); const int e = 4 * i, jj = e & 127, ii = (e >> 7) & 127;
          const bool keep = (jj >> 6) <= (ii >> 6);
          *((GAS unsigned long long*)Wsm + i) = keep ? ((unsigned long long)pk2(v.x, v.y) | ((unsigned long long)pk2(v.z, v.w) << 32)) : 0ull; } }
}

namespace att {
constexpr int KP = 272, VP = 544;
constexpr int L_K0 = 0, L_K1 = 64 * KP, L_V = 2 * 64 * KP, L_TAB = L_V + 64 * VP, L_END = L_TAB + 320 * 4;
constexpr int L_X = 0;
static_assert(65536 <= L_TAB && L_END <= RING_BYTES, "attention LDS map");
__device__ __forceinline__ pg8::bf16x8 mk8(v4i16_t lo, v4i16_t hi) { return (pg8::bf16x8){lo[0], lo[1], lo[2], lo[3], hi[0], hi[1], hi[2], hi[3]}; }
__device__ __forceinline__ v4i16_t vtr(lptr p) { return __builtin_amdgcn_ds_read_tr16_b64_v4i16((LAS v4i16_t*)p); }

__device__ __forceinline__ void attn_unit(lptr lds, const bf16_t* Q, const bf16_t* K, const bf16_t* V, bf16_t* MIX, const float* relb, const float* subg, float lam, int b, int h, int c) {
    const int tid = threadIdx.x, lane = tid & 63, w = __builtin_amdgcn_readfirstlane(tid >> 6), m = w >> 2, rg = w & 3, ql = lane & 15, fq = lane >> 4;
    const size_t tok0 = (size_t)b * SEQ + 64 * c;
    __syncthreads();
    if (tid < 320) {
        const int rel = tid - 255, n = rel < 0 ? -rel : rel;
        int bk;
        if (n < 8) bk = n; else { int lg = 8 + (int)(logf((float)n / 8.0f) / 2.7725887f * 8.0f); bk = lg < 15 ? lg : 15; }
        bk += (rel > 0) ? 16 : 0;
        ((LAS float*)(lds + L_TAB))[tid] = relb[bk * NH + h] * LOG2E;
    }
    const float cb = relb[15 * NH + h] * LOG2E;
    pg8::bf16x8 qf[4];
    { const bf16_t* qp = Q + (tok0 + 16 * rg + ql) * 1024 + h * 256 + m * 128 + 8 * fq;
#pragma unroll
      for (int ds = 0; ds < 4; ++ds) qf[ds] = *(const pg8::bf16x8*)(qp + 32 * ds); }
    f32x4 o[16];
#pragma unroll
    for (int i = 0; i < 16; ++i) o[i] = (f32x4){0.f, 0.f, 0.f, 0.f};
    float mrun = -1e30f, lsum = 0.f;
    const int krow = tid >> 4, kcc = tid & 15, vrow = tid >> 5, vcc = tid & 31;
    const bf16_t* kg = K + ((size_t)b * SEQ + krow) * 1024 + h * 256 + kcc * 8;
    const bf16_t* vg = V + ((size_t)b * SEQ + vrow) * 1024 + h * 256 + vcc * 8;
    v4u st[8];
#define ATT_ISSUE(t) do { const size_t ko = (size_t)(t) * 64 * 1024; \
        st[0] = *(const v4u*)(kg + ko); st[1] = *(const v4u*)(kg + ko + 32 * 1024); st[2] = *(const v4u*)(kg + ko + 128); st[3] = *(const v4u*)(kg + ko + 32 * 1024 + 128); \
        st[4] = *(const v4u*)(vg + ko); st[5] = *(const v4u*)(vg + ko + 16 * 1024); st[6] = *(const v4u*)(vg + ko + 32 * 1024); st[7] = *(const v4u*)(vg + ko + 48 * 1024); } while (0)
#define ATT_WRITE() do { \
        *(LAS v4u*)(lds + L_K0 + krow * KP + kcc * 16) = st[0]; *(LAS v4u*)(lds + L_K0 + (krow + 32) * KP + kcc * 16) = st[1]; \
        *(LAS v4u*)(lds + L_K1 + krow * KP + kcc * 16) = st[2]; *(LAS v4u*)(lds + L_K1 + (krow + 32) * KP + kcc * 16) = st[3]; \
        *(LAS v4u*)(lds + L_V + vrow * VP + vcc * 16) = st[4]; *(LAS v4u*)(lds + L_V + (vrow + 16) * VP + vcc * 16) = st[5]; \
        *(LAS v4u*)(lds + L_V + (vrow + 32) * VP + vcc * 16) = st[6]; *(LAS v4u*)(lds + L_V + (vrow + 48) * VP + vcc * 16) = st[7]; } while (0)
    const lptr kbase = lds + (m ? L_K1 : L_K0) + ql * KP + fq * 16;
    const lptr vbase = lds + L_V + (4 * fq + (ql >> 2)) * VP + (ql & 3) * 8;
    ATT_ISSUE(0);
    for (int t = 0; t <= c; ++t) {
        if (t > 0) __syncthreads();
        ATT_WRITE();
        __syncthreads();
        if (t < c) ATT_ISSUE(t + 1);
        const bool nearb = (t >= c - 3);
        f32x4 s[4];
#pragma unroll
        for (int kb = 0; kb < 4; ++kb) {
            const float ini = nearb ? 0.f : cb; f32x4 a = (f32x4){ini, ini, ini, ini};
#pragma unroll
            for (int ds = 0; ds < 4; ++ds) { const pg8::bf16x8 kf = *(const LAS pg8::bf16x8*)(kbase + kb * 16 * KP + ds * 64); a = __builtin_amdgcn_mfma_f32_16x16x32_bf16(kf, qf[ds], a, 0, 0, 0); }
            s[kb] = a;
        }
        if (nearb) {
            const int ib = 64 * (t - c) + 4 * fq - 16 * rg - ql + 255;
            const LAS float* tb = (const LAS float*)(lds + L_TAB) + ib;
#pragma unroll
            for (int kb = 0; kb < 4; ++kb)
#pragma unroll
                for (int r = 0; r < 4; ++r) s[kb][r] += tb[16 * kb + r];
        }
        float tmax = fmaxf(fmaxf(fmaxf(s[0][0], s[0][1]), fmaxf(s[0][2], s[0][3])), fmaxf(fmaxf(s[1][0], s[1][1]), fmaxf(s[1][2], s[1][3])));
        tmax = fmaxf(tmax, fmaxf(fmaxf(fmaxf(s[2][0], s[2][1]), fmaxf(s[2][2], s[2][3])), fmaxf(fmaxf(s[3][0], s[3][1]), fmaxf(s[3][2], s[3][3]))));
        tmax = fmaxf(tmax, __shfl_xor(tmax, 16)); tmax = fmaxf(tmax, __shfl_xor(tmax, 32));
        const float mnew = fmaxf(mrun, tmax);
        if (__any(mnew > mrun)) {
            const float alpha = __builtin_amdgcn_exp2f(mrun - mnew);
            lsum *= alpha;
#pragma unroll
            for (int i = 0; i < 16; ++i) o[i] = o[i] * alpha;
            mrun = mnew;
        }
        float ps = 0.f;
#pragma unroll
        for (int kb = 0; kb < 4; ++kb)
#pragma unroll
            for (int r = 0; r < 4; ++r) { s[kb][r] = __builtin_amdgcn_exp2f(s[kb][r] - mrun); ps += s[kb][r]; }
        lsum += ps;
        pg8::bf16x8 pa[2];
#pragma unroll
        for (int ks = 0; ks < 2; ++ks) { v4u pw; pw.x = pg8::cvt_pk_bf16(s[2 * ks][0], s[2 * ks][1]); pw.y = pg8::cvt_pk_bf16(s[2 * ks][2], s[2 * ks][3]);
            pw.z = pg8::cvt_pk_bf16(s[2 * ks + 1][0], s[2 * ks + 1][1]); pw.w = pg8::cvt_pk_bf16(s[2 * ks + 1][2], s[2 * ks + 1][3]); pa[ks] = __builtin_bit_cast(pg8::bf16x8, pw); }
#pragma unroll
        for (int ks = 0; ks < 2; ++ks)
#pragma unroll
            for (int blk = 0; blk < 16; ++blk) {
                const v4i16_t lo = vtr(vbase + ks * 32 * VP + blk * 32), hi = vtr(vbase + ks * 32 * VP + 16 * VP + blk * 32);
                o[blk] = __builtin_amdgcn_mfma_f32_16x16x32_bf16(mk8(lo, hi), pa[ks], o[blk], 0, 0, 0);
            }
    }
#undef ATT_ISSUE
#undef ATT_WRITE
    lsum += __shfl_xor(lsum, 16); lsum += __shfl_xor(lsum, 32);
    const float inv = 1.0f / lsum;
    __syncthreads();
    LAS f32x4* xo = (LAS f32x4*)(lds + L_X) + rg * 1024 + lane;
    if (m == 1) {
#pragma unroll
        for (int i = 0; i < 16; ++i) xo[i * 64] = o[i] * inv;
    }
    __syncthreads();
    if (m == 0) {
        float ss = 0.f;
#pragma unroll
        for (int i = 0; i < 16; ++i) { const f32x4 o2 = xo[i * 64]; o[i] = o[i] * inv - o2 * lam; ss += (o[i][0] * o[i][0] + o[i][1] * o[i][1]) + (o[i][2] * o[i][2] + o[i][3] * o[i][3]); }
        ss += __shfl_xor(ss, 16); ss += __shfl_xor(ss, 32);
        const float rn = (1.0f / sqrtf(ss * (1.0f / 256.0f) + EPS)) * 0.8f;
        bf16_t* op = MIX + (tok0 + 16 * rg + ql) * 2048 + h * 256 + 4 * fq;
#pragma unroll
        for (int i = 0; i < 16; ++i) { const f32x4 g = *(const f32x4*)(subg + 16 * i + 4 * fq); const f32x4 v = o[i] * rn * g;
            u32x2 wv; wv.x = pg8::cvt_pk_bf16(v[0], v[1]); wv.y = pg8::cvt_pk_bf16(v[2], v[3]); *(u32x2*)(op + 16 * i) = wv; }
    }
}
constexpr int GP = 288;
__device__ __forceinline__ void gmlp_unit(lptr lds, const bf16_t* U, const bf16_t* Gv, const float* lnstat, const float* lng, const float* lnb, const bf16_t* Wsm, const float* gb, bf16_t* MIX, int b, int n, int g) {
    const int tid = threadIdx.x, lane = tid & 63, w = __builtin_amdgcn_readfirstlane(tid >> 6), ql = lane & 15, fq = lane >> 4;
    const size_t tok0 = (size_t)b * SEQ + 128 * n;
    __syncthreads();
    { const int cc = tid & 15, r0 = tid >> 4;
      float gg[8], bb[8];
#pragma unroll
      for (int e = 0; e < 8; ++e) { gg[e] = lng[g * 128 + cc * 8 + e]; bb[e] = lnb[g * 128 + cc * 8 + e]; }
#pragma unroll
      for (int i = 0; i < 4; ++i) { const int row = r0 + 32 * i; const size_t tok = tok0 + row;
          const v4u raw = *(const v4u*)(Gv + tok * 1024 + g * 128 + cc * 8);
          const float s1 = lnstat[2 * tok], s2 = lnstat[2 * tok + 1]; const float mean = s1 * (1.0f / GW); const float var = s2 * (1.0f / GW) - mean * mean; const float rstd = 1.0f / sqrtf(var + EPS);
          float y[8]; y[0] = bf_lo(raw.x); y[1] = bf_hi(raw.x); y[2] = bf_lo(raw.y); y[3] = bf_hi(raw.y); y[4] = bf_lo(raw.z); y[5] = bf_hi(raw.z); y[6] = bf_lo(raw.w); y[7] = bf_hi(raw.w);
#pragma unroll
          for (int e = 0; e < 8; ++e) y[e] = (y[e] - mean) * rstd * gg[e] + bb[e];
          v4u ov; ov.x = pg8::cvt_pk_bf16(y[0], y[1]); ov.y = pg8::cvt_pk_bf16(y[2], y[3]); ov.z = pg8::cvt_pk_bf16(y[4], y[5]); ov.w = pg8::cvt_pk_bf16(y[6], y[7]);
          *(LAS v4u*)(lds + row * GP + cc * 16) = ov; } }
    __syncthreads();
    pg8::bf16x8 wf[4];
    { const bf16_t* wp = Wsm + ((size_t)g * 128 + 16 * w + ql) * 128 + 4 * fq;
#pragma unroll
      for (int s = 0; s < 4; ++s) { const u32x2 lo = *(const u32x2*)(wp + 32 * s), hi = *(const u32x2*)(wp + 32 * s + 16); v4u t4; t4.x = lo.x; t4.y = lo.y; t4.z = hi.x; t4.w = hi.y; wf[s] = __builtin_bit_cast(pg8::bf16x8, t4); } }
    f32x4 acc[8];
#pragma unroll
    for (int i = 0; i < 8; ++i) acc[i] = (f32x4){0.f, 0.f, 0.f, 0.f};
    const lptr vbase = lds + (4 * fq + (ql >> 2)) * GP + (ql & 3) * 8;
#pragma unroll
    for (int s = 0; s < 4; ++s)
#pragma unroll
        for (int blk = 0; blk < 8; ++blk) {
            const v4i16_t lo = vtr(vbase + s * 32 * GP + blk * 32), hi = vtr(vbase + s * 32 * GP + 16 * GP + blk * 32);
            acc[blk] = __builtin_amdgcn_mfma_f32_16x16x32_bf16(mk8(lo, hi), wf[s], acc[blk], 0, 0, 0);
        }
    const int irow = 16 * w + ql; const float bias = gb[g * 128 + irow]; const size_t tok = tok0 + irow;
    const bf16_t* up = U + tok * 1024 + g * 128 + 4 * fq; bf16_t* op = MIX + tok * 2048 + 1024 + g * 128 + 4 * fq;
#pragma unroll
    for (int blk = 0; blk < 8; ++blk) { const u32x2 uw = *(const u32x2*)(up + 16 * blk);
        const float o0 = bf_lo(uw.x) * (acc[blk][0] + bias), o1 = bf_hi(uw.x) * (acc[blk][1] + bias), o2 = bf_lo(uw.y) * (acc[blk][2] + bias), o3 = bf_hi(uw.y) * (acc[blk][3] + bias);
        u32x2 wv; wv.x = pg8::cvt_pk_bf16(o0, o1); wv.y = pg8::cvt_pk_bf16(o2, o3); *(u32x2*)(op + 16 * blk) = wv; }
}
}

__device__ __forceinline__ void p7_final(float* out, const float* ss3, const float* gfin, int vcu, int G, int wave, int lane) {
    const int gw = vcu * NWAVES + wave, NGW = G * NWAVES;
    f32x4 g[8];
#pragma unroll
    for (int j = 0; j < 8; ++j) g[j] = *((const GAS f32x4*)gfin + lane + 64 * j);
    for (int m = gw; m < M; m += NGW) {
        const float r = 1.0f / sqrtf(ss3[m] * (1.0f / DM) + EPS);
        GAS f32x4* xr = (GAS f32x4*)(out + (size_t)m * DM) + lane;
#pragma unroll
        for (int j = 0; j < 8; ++j) { f32x4 v = xr[64 * j]; v = v * r * g[j]; xr[64 * j] = v; }
    }
}
#ifndef MK_N_LAUNCHES
#define MK_N_LAUNCHES 1
#endif
constexpr int N_PHASES = 8;
struct Args { const float* in[22]; float* out; unsigned char* ws; int ph_lo, ph_hi, li, pad; };
__global__ void __launch_bounds__(NWAVES * 64, 2) mk_fwd(Args args) {
    extern __shared__ __attribute__((aligned(16))) unsigned char lds_raw[];
    const lptr lds = (lptr)lds_raw;
    volatile LAS unsigned* MISC = (volatile LAS unsigned*)(lds + MISC_OFF);
    const int tid = threadIdx.x, lane = tid & 63, wave = __builtin_amdgcn_readfirstlane(tid >> 6);
    const int G = gridDim.x; const int bx = blockIdx.x; const int vcu = (G % 8 == 0) ? (bx % 8) * (G / 8) + bx / 8 : bx;
    unsigned char* ws = args.ws;
    gu32* ctl = (gu32*)(ws + WS_CTL);
    for (int u = tid; u < (LDS_BYTES - LDSCTL_OFF) / 4; u += NWAVES * 64) ((LAS unsigned*)(lds + LDSCTL_OFF))[u] = 0u;
    __syncthreads();
    const int lo = args.ph_lo, hi = args.ph_hi;
    const bool use_bar = (hi - lo) > 1;
    XcdBarrier bar; bar.bar = (unsigned*)(ctl + CW_BAR); bar.x = 0; bar.st = nullptr;
    if (use_bar) bar = xcd_barrier_post((unsigned*)(ctl + CW_BAR), MISC + 8);
#define IN(k) (lo <= (k) && (k) < hi)
#define SEAM(k) do { if (IN(k) && IN((k) + 1)) xcd_barrier(bar); } while (0)

    bf16_t* Win_t = (bf16_t*)(ws + WS_WIN); bf16_t* Wout_t = (bf16_t*)(ws + WS_WOUT); bf16_t* W13_t = (bf16_t*)(ws + WS_W13); bf16_t* W2_t = (bf16_t*)(ws + WS_W2);
    bf16_t* Wg_t = (bf16_t*)(ws + WS_WG); bf16_t* Wup_t = (bf16_t*)(ws + WS_WUP); bf16_t* Wsm = (bf16_t*)(ws + WS_WSM);
    bf16_t* PB = (bf16_t*)(ws + WS_PB); bf16_t* UPB = (bf16_t*)(ws + WS_UP); bf16_t* A0 = (bf16_t*)(ws + WS_A0); bf16_t* MIX = (bf16_t*)(ws + WS_A0); bf16_t* H2B = (bf16_t*)(ws + WS_A0);
    bf16_t* QKVUG = (bf16_t*)(ws + WS_QKVUG); bf16_t* H1B = (bf16_t*)(ws + WS_H1B); bf16_t* HID = (bf16_t*)(ws + WS_HID);
    float* lnstat = (float*)(ws + WS_LNSTAT); float* ss1 = (float*)(ws + WS_SS1); float* ss3 = (float*)(ws + WS_SS3);

    if (IN(0)) {
        P0Args A{args.in[0], args.in[1], args.in[2], args.in[3], args.in[4], args.in[5], args.in[15], args.in[17], args.in[18], args.in[19], args.in[20], args.in[21], ws};
        p0_prologue(A, lds, vcu, G, wave, lane);
    }
    SEAM(0);
    if (IN(1)) {
        { pg8::Gemm g{A0, Win_t, M, IN_DIM, DM}; pg8::StaticOrder S; S.init(M, IN_DIM, G, bx);
          pg8::EpiIn E{QKVUG, lnstat, QSCALE};
          pg8::gemm_phase<pg8::EpiIn, pg8::StaticOrder, true, true>(lds + RING_OFF, g, S, E); }
        { pg8::Gemm g{PB, Wup_t, M, DM, PLE}; pg8::StaticOrder S; S.init(M, DM, G, bx);
          pg8::EpiPlain E{UPB, DM};
          pg8::gemm_phase<pg8::EpiPlain, pg8::StaticOrder, true, true>(lds + RING_OFF, g, S, E); }
    }
    SEAM(1);
    if (IN(2)) {
        const bf16_t* Qb = QKVUG; const bf16_t* Kb = QKVUG + (size_t)M * 1024; const bf16_t* Vb = QKVUG + (size_t)2 * M * 1024;
        const bf16_t* Ub = QKVUG + (size_t)3 * M * 1024; const bf16_t* Gb = QKVUG + (size_t)4 * M * 1024;
        float lam;
        { const float *q1 = args.in[7], *k1 = args.in[8], *q2 = args.in[9], *k2 = args.in[10];
          const float a = wave_sum(q1[lane] * k1[lane] + q1[lane + 64] * k1[lane + 64]), c2 = wave_sum(q2[lane] * k2[lane] + q2[lane + 64] * k2[lane + 64]);
          lam = expf(a) - expf(c2) + 0.2f; }
        for (int pi = vcu; pi < 512; pi += G) {
            const int bh = pi >> 4, s = pi & 15;
            att::attn_unit(lds, Qb, Kb, Vb, MIX, args.in[12], args.in[11], lam, bh >> 2, bh & 3, 31 - s);
            att::attn_unit(lds, Qb, Kb, Vb, MIX, args.in[12], args.in[11], lam, bh >> 2, bh & 3, s);
        }
        for (int ui = vcu; ui < 1024; ui += G)
            att::gmlp_unit(lds, Ub, Gb, lnstat, args.in[13], args.in[14], Wsm, args.in[16], MIX, ui >> 7, (ui >> 3) & 15, ui & 7);
        __syncthreads();
    }
    SEAM(2);
    if (IN(3)) {
        pg8::Gemm g{MIX, Wout_t, M, DM, DM}; pg8::StaticOrder S; S.init(M, DM, G, bx);
        pg8::EpiResid E{args.in[0], args.out, H1B, ss1, DM};
        pg8::gemm_phase<pg8::EpiResid, pg8::StaticOrder, true, true>(lds + RING_OFF, g, S, E);
    }
    SEAM(3);
    if (IN(4)) {
        pg8::Gemm g{H1B, W13_t, M, 2 * FF, DM}; pg8::StaticOrder S; S.init(M, 2 * FF, G, bx);
        pg8::EpiSwiGLU E{HID, ss1, FF};
        pg8::gemm_phase<pg8::EpiSwiGLU, pg8::StaticOrder, true, true>(lds + RING_OFF, g, S, E);
    }
    SEAM(4);
    if (IN(5)) {
        pg8::Gemm g{HID, W2_t, M, DM, FF}; pg8::StaticOrder S; S.init(M, DM, G, bx);
        pg8::EpiResid E{args.out, args.out, H2B, nullptr, DM};
        pg8::gemm_phase<pg8::EpiResid, pg8::StaticOrder, true, true>(lds + RING_OFF, g, S, E);
    }
    SEAM(5);
    if (IN(6)) {
        pg8::Gemm g{H2B, Wg_t, M, DM, DM}; pg8::StaticOrder S; S.init(M, DM, G, bx);
        pg8::EpiGate E{args.out, args.out, UPB, ss3, DM};
        pg8::gemm_phase<pg8::EpiGate, pg8::StaticOrder, true, true>(lds + RING_OFF, g, S, E);
    }
    SEAM(6);
    if (IN(7)) p7_final(args.out, ss3, args.in[6], vcu, G, wave, lane);
#undef IN
#undef SEAM
}

extern "C" void kernel_launch(void* const* d_in, const int* in_sizes, int n_in, void* d_out, int out_size, void* d_ws, size_t ws_size, hipStream_t stream) {
    static int grid = 0;
    if (grid == 0) {
        if (n_in != 22 || in_sizes[0] != M * DM || out_size != M * DM || ws_size < WS_END) {
            fprintf(stderr, "kernel_launch: unexpected shapes (n_in %d, in0 %d, out %d, ws %zu); nothing launched\n", n_in, n_in > 0 ? in_sizes[0] : -1, out_size, ws_size); grid = -1; return; }
        int dev = 0, cus = 0, per_cu = 0;
        if (hipGetDevice(&dev) != hipSuccess || hipDeviceGetAttribute(&cus, hipDeviceAttributeMultiprocessorCount, dev) != hipSuccess) { grid = -1; return; }
        if (hipFuncSetAttribute((const void*)mk_fwd, hipFuncAttributeMaxDynamicSharedMemorySize, LDS_BYTES) != hipSuccess) { fprintf(stderr, "kernel_launch: hipFuncSetAttribute failed\n"); grid = -1; return; }
        if (hipOccupancyMaxActiveBlocksPerMultiprocessor(&per_cu, (const void*)mk_fwd, NWAVES * 64, LDS_BYTES) != hipSuccess || per_cu < 1) {
            fprintf(stderr, "kernel_launch: occupancy query reports %d workgroups per CU\n", per_cu); per_cu = 1; }
        (void)hipGetLastError();
        grid = cus;
    }
    if (grid < 0) return;
    if (hipMemsetAsync((char*)d_ws + WS_CTL, 0, CTL_ZERO_BYTES, stream) != hipSuccess) { fprintf(stderr, "kernel_launch: hipMemsetAsync failed\n"); return; }
    Args a{};
    for (int i = 0; i < 22; ++i) a.in[i] = (const float*)d_in[i];
    a.out = (float*)d_out; a.ws = (unsigned char*)d_ws;
    for (int li = 0; li < MK_N_LAUNCHES; ++li) {
        a.ph_lo = (MK_N_LAUNCHES == 1) ? 0 : li; a.ph_hi = (MK_N_LAUNCHES == 1) ? N_PHASES : li + 1; a.li = li;
#if MK_N_LAUNCHES == 1
        void* kargs[] = {(void*)&a};
        const hipError_t le = hipLaunchCooperativeKernel((const void*)mk_fwd, dim3(grid), dim3(NWAVES * 64), kargs, LDS_BYTES, stream);
#else
        hipLaunchKernelGGL(mk_fwd, dim3(grid), dim3(NWAVES * 64), LDS_BYTES, stream, a);
        const hipError_t le = hipPeekAtLastError();
#endif
        if (le != hipSuccess) { fprintf(stderr, "kernel_launch: launch %d failed: %s\n", li, hipGetErrorName(le)); break; }
    }
}
```

```cpp
#define MK_N_LAUNCHES 1
#include <hip/hip_runtime.h>
#include <cstdio>
#include <cstdint>
#include <cmath>
namespace pg8 {
#define PG8_LAS __attribute__((address_space(3)))
typedef unsigned short bf16_t;
typedef short bf16x8 __attribute__((ext_vector_type(8)));
typedef float f32x4 __attribute__((ext_vector_type(4)));
typedef unsigned u32x4 __attribute__((ext_vector_type(4)));
constexpr int BM = 256, BK = 64, HALF = 128, HTB = HALF * BK * 2  , STAGE_BYTES = 8 * HTB, NXCD = 8, WGM = 8;

__host__ __device__ __forceinline__ int lds_byte(int r, int c) { const int st = (r >> 4) * 2 + (c >> 5), rr = r & 15, cc = c & 31, ob = rr * 64 + cc * 2; return st * 1024 + (ob ^ (((ob >> 9) & 1) << 5)); }
__host__ __device__ __forceinline__ void stage_rc(int b, int& R, int& C) { const int st = b / 1024, sb = b % 1024, swz = sb ^ (((sb >> 9) & 1) << 5); R = (st >> 1) * 16 + swz / 64; C = (st & 1) * 32 + (swz % 64) / 2; }
__host__ __device__ __forceinline__ int perm32(int rho) { const int n = rho >> 4, i = rho & 15; return 8 * (i >> 2) + 4 * n + (i & 3); }

struct Unit { int pm, pn; };
struct Gemm { const bf16_t* A; const bf16_t* Bt; int M, N, K; };

struct StaticOrder {
    int nM, nN, nwg, G, c;
    __host__ __device__ void init(int M, int N, int G_, int c_) { nM = M / BM; nN = N / BM; nwg = nM * nN; G = G_; c = c_; }
    __host__ __device__ bool next(int i, Unit& u) const {
        const long L = (long)i * G + c; if (L >= nwg) return false;
        int wgid = (int)L; { const int q = nwg / NXCD, r = nwg % NXCD, xcd = wgid % NXCD, off = wgid / NXCD; wgid = (xcd < r ? xcd * (q + 1) : r * (q + 1) + (xcd - r) * q) + off; }
        const int nig = WGM * nN, gid = wgid / nig, fm = gid * WGM, gsz = (nM - fm) < WGM ? (nM - fm) : WGM;
        u.pm = fm + ((wgid % nig) % gsz); u.pn = (wgid % nig) / gsz; return true;
    }
    __device__ __forceinline__ void a_ready(const Unit&) const {}
    __device__ __forceinline__ void done(const Unit&) const {}
};
__device__ __forceinline__ unsigned cvt_pk_bf16(float lo, float hi) { unsigned r; asm volatile("v_cvt_pk_bf16_f32 %0, %1, %2" : "=v"(r) : "v"(lo), "v"(hi)); return r; }
typedef float f32x2 __attribute__((ext_vector_type(2)));
typedef unsigned u32x2 __attribute__((ext_vector_type(2)));
constexpr int MROWS = 16384;
__device__ __forceinline__ float gelu_tanh(float x) {
    const float u = x * (1.0f + 0.044715f * x * x);
    const float e = __builtin_amdgcn_exp2f(-2.3022082f * u);
    return x * __builtin_amdgcn_rcpf(1.0f + e);
}
__device__ __forceinline__ float sigmoid_f(float a) { return __builtin_amdgcn_rcpf(1.0f + __builtin_amdgcn_exp2f(-1.4426950409f * a)); }

struct EpiIn {
    static constexpr bool PERM = true, AFTER_DRAIN = false;
    bf16_t* O; float* lnstat; float qscale;
    __device__ __forceinline__ void operator()(const f32x4 (&acc)[2][2][4][2], const Unit& u, int wr, int wc, int fr, int fq) const {
        const int t = u.pn >> 2;
        bf16_t* base = O + (size_t)t * ((size_t)MROWS * 1024);
        const int row0 = u.pm * BM + wr * 64 + fr, col0 = (u.pn & 3) * 256 + wc * 32 + 8 * fq;
        const float sc = (t == 0) ? qscale : 1.0f;
#pragma unroll
        for (int ai = 0; ai < 2; ++ai)
#pragma unroll
            for (int m = 0; m < 4; ++m) {
                const int row = row0 + ai * HALF + m * 16;
                bf16_t* rowp = base + (size_t)row * 1024 + col0;
                float s1 = 0.f, s2 = 0.f;
#pragma unroll
                for (int bj = 0; bj < 2; ++bj) {
                    f32x4 v0 = acc[ai][bj][m][0], v1 = acc[ai][bj][m][1];
                    if (t >= 3) {
#pragma unroll
                        for (int e = 0; e < 4; ++e) { v0[e] = gelu_tanh(v0[e]); v1[e] = gelu_tanh(v1[e]); }
                    } else { v0 = v0 * sc; v1 = v1 * sc; }
                    if (t == 4) {
                        s1 += (v0[0] + v0[1]) + (v0[2] + v0[3]) + (v1[0] + v1[1]) + (v1[2] + v1[3]);
                        s2 += (v0[0] * v0[0] + v0[1] * v0[1]) + (v0[2] * v0[2] + v0[3] * v0[3]) + (v1[0] * v1[0] + v1[1] * v1[1]) + (v1[2] * v1[2] + v1[3] * v1[3]);
                    }
                    u32x4 w; w.x = cvt_pk_bf16(v0[0], v0[1]); w.y = cvt_pk_bf16(v0[2], v0[3]); w.z = cvt_pk_bf16(v1[0], v1[1]); w.w = cvt_pk_bf16(v1[2], v1[3]);
                    *(u32x4*)(rowp + bj * HALF) = w;
                }
                if (t == 4) {
                    s1 += __shfl_xor(s1, 16); s1 += __shfl_xor(s1, 32); s2 += __shfl_xor(s2, 16); s2 += __shfl_xor(s2, 32);
                    if (fq == 0) { atomicAdd(lnstat + 2 * row, s1); atomicAdd(lnstat + 2 * row + 1, s2); }
                }
            }
    }
};
struct EpiPlain {
    static constexpr bool PERM = true, AFTER_DRAIN = false;
    bf16_t* O; int ldc;
    __device__ __forceinline__ void operator()(const f32x4 (&acc)[2][2][4][2], const Unit& u, int wr, int wc, int fr, int fq) const {
        const int row0 = u.pm * BM + wr * 64 + fr, col0 = u.pn * BM + wc * 32 + 8 * fq;
#pragma unroll
        for (int ai = 0; ai < 2; ++ai)
#pragma unroll
            for (int m = 0; m < 4; ++m) {
                bf16_t* rowp = O + (size_t)(row0 + ai * HALF + m * 16) * ldc + col0;
#pragma unroll
                for (int bj = 0; bj < 2; ++bj) {
                    const f32x4 v0 = acc[ai][bj][m][0], v1 = acc[ai][bj][m][1];
                    u32x4 w; w.x = cvt_pk_bf16(v0[0], v0[1]); w.y = cvt_pk_bf16(v0[2], v0[3]); w.z = cvt_pk_bf16(v1[0], v1[1]); w.w = cvt_pk_bf16(v1[2], v1[3]);
                    *(u32x4*)(rowp + bj * HALF) = w;
                }
            }
    }
};
struct EpiRes3 {
    static constexpr bool PERM = false, AFTER_DRAIN = false;
    const float* base; bf16_t* ob; float* ss; int ldc;
    __device__ __forceinline__ void operator()(const f32x4 (&acc)[2][2][4][2], const Unit& u, int wr, int wc, int fr, int fq) const {
        const int row0 = u.pm * BM + wr * 64 + fr, col0 = u.pn * BM + wc * 32 + 4 * fq;
#pragma unroll
        for (int ai = 0; ai < 2; ++ai)
#pragma unroll
            for (int m = 0; m < 4; ++m) {
                const int row = row0 + ai * HALF + m * 16; const size_t off = (size_t)row * ldc + col0; float s = 0.f;
#pragma unroll
                for (int bj = 0; bj < 2; ++bj)
#pragma unroll
                    for (int n = 0; n < 2; ++n) {
                        const f32x4 bs = *(const f32x4*)(base + off + bj * HALF + n * 16);
                        const f32x4 o = bs + acc[ai][bj][m][n];
                        u32x2 w; w.x = cvt_pk_bf16(o[0], o[1]); w.y = cvt_pk_bf16(o[2], o[3]);
                        *(u32x2*)(ob + off + bj * HALF + n * 16) = w;
                        s += (o[0] * o[0] + o[1] * o[1]) + (o[2] * o[2] + o[3] * o[3]);
                    }
                s += __shfl_xor(s, 16); s += __shfl_xor(s, 32); if (fq == 0) atomicAdd(ss + row, s);
            }
    }
};
struct EpiRes5 {
    static constexpr bool PERM = false, AFTER_DRAIN = false;
    const bf16_t* base; bf16_t* ob; int ldc;
    __device__ __forceinline__ void operator()(const f32x4 (&acc)[2][2][4][2], const Unit& u, int wr, int wc, int fr, int fq) const {
        const int row0 = u.pm * BM + wr * 64 + fr, col0 = u.pn * BM + wc * 32 + 4 * fq;
#pragma unroll
        for (int ai = 0; ai < 2; ++ai)
#pragma unroll
            for (int m = 0; m < 4; ++m) {
                const size_t off = (size_t)(row0 + ai * HALF + m * 16) * ldc + col0;
#pragma unroll
                for (int bj = 0; bj < 2; ++bj)
#pragma unroll
                    for (int n = 0; n < 2; ++n) {
                        const u32x2 bw = *(const u32x2*)(base + off + bj * HALF + n * 16);
                        const f32x4 a = acc[ai][bj][m][n];
                        u32x2 w; w.x = cvt_pk_bf16(__uint_as_float(bw.x << 16) + a[0], __uint_as_float(bw.x & 0xffff0000u) + a[1]);
                        w.y = cvt_pk_bf16(__uint_as_float(bw.y << 16) + a[2], __uint_as_float(bw.y & 0xffff0000u) + a[3]);
                        *(u32x2*)(ob + off + bj * HALF + n * 16) = w;
                    }
            }
    }
};
struct EpiSwiGLU {
    static constexpr bool PERM = true, AFTER_DRAIN = false;
    bf16_t* O; const float* ss; int ldc;
    __device__ __forceinline__ void operator()(const f32x4 (&acc)[2][2][4][2], const Unit& u, int wr, int wc, int fr, int fq) const {
        const int row0 = u.pm * BM + wr * 64 + fr, col0 = u.pn * HALF + wc * 32 + 8 * fq;
#pragma unroll
        for (int ai = 0; ai < 2; ++ai)
#pragma unroll
            for (int m = 0; m < 4; ++m) {
                const int row = row0 + ai * HALF + m * 16;
                const float r = __builtin_amdgcn_rsqf(ss[row] * (1.0f / 2048.0f) + 1e-6f);
                float hv[8];
#pragma unroll
                for (int n = 0; n < 2; ++n)
#pragma unroll
                    for (int e = 0; e < 4; ++e) { const float a = r * acc[ai][0][m][n][e], b = r * acc[ai][1][m][n][e]; hv[4 * n + e] = a * sigmoid_f(a) * b; }
                u32x4 w; w.x = cvt_pk_bf16(hv[0], hv[1]); w.y = cvt_pk_bf16(hv[2], hv[3]); w.z = cvt_pk_bf16(hv[4], hv[5]); w.w = cvt_pk_bf16(hv[6], hv[7]);
                *(u32x4*)(O + (size_t)row * ldc + col0) = w;
            }
    }
};
struct EpiGate {
    static constexpr bool PERM = false, AFTER_DRAIN = false;
    const bf16_t* base; float* out; const bf16_t* up; float* ss; int ldc;
    __device__ __forceinline__ void operator()(const f32x4 (&acc)[2][2][4][2], const Unit& u, int wr, int wc, int fr, int fq) const {
        const int row0 = u.pm * BM + wr * 64 + fr, col0 = u.pn * BM + wc * 32 + 4 * fq;
#pragma unroll
        for (int ai = 0; ai < 2; ++ai)
#pragma unroll
            for (int m = 0; m < 4; ++m) {
                const int row = row0 + ai * HALF + m * 16; const size_t off = (size_t)row * ldc + col0; float s = 0.f;
#pragma unroll
                for (int bj = 0; bj < 2; ++bj)
#pragma unroll
                    for (int n = 0; n < 2; ++n) {
                        const u32x2 bw = *(const u32x2*)(base + off + bj * HALF + n * 16);
                        const u32x2 uw = *(const u32x2*)(up + off + bj * HALF + n * 16);
                        const f32x4 a = acc[ai][bj][m][n];
                        f32x4 o;
                        o[0] = __uint_as_float(bw.x << 16) + __uint_as_float(uw.x << 16) * sigmoid_f(a[0]);
                        o[1] = __uint_as_float(bw.x & 0xffff0000u) + __uint_as_float(uw.x & 0xffff0000u) * sigmoid_f(a[1]);
                        o[2] = __uint_as_float(bw.y << 16) + __uint_as_float(uw.y << 16) * sigmoid_f(a[2]);
                        o[3] = __uint_as_float(bw.y & 0xffff0000u) + __uint_as_float(uw.y & 0xffff0000u) * sigmoid_f(a[3]);
                        *(f32x4*)(out + off + bj * HALF + n * 16) = o;
                        s += (o[0] * o[0] + o[1] * o[1]) + (o[2] * o[2] + o[3] * o[3]);
                    }
                s += __shfl_xor(s, 16); s += __shfl_xor(s, 32); if (fq == 0) atomicAdd(ss + row, s);
            }
    }
};

template <class Epi, class Sched, bool ALIGN_EPI = false, bool SP2 = false>
__device__ __forceinline__ void gemm_phase(PG8_LAS unsigned char* lds, const Gemm g, const Sched& S, const Epi& E) {
    const int tid = threadIdx.x, wid = __builtin_amdgcn_readfirstlane(tid >> 6), lane = tid & 63, wr = wid >> 2, wc = wid & 3, fr = lane & 15, fq = lane >> 4;
    const int K = g.K, nt = K / BK;
    unsigned voffA[2], voffB[2];
#pragma unroll
    for (int i = 0; i < 2; ++i) { int R, C; stage_rc(tid * 16 + i * 8192, R, C); const int Rb = Epi::PERM ? ((R & ~31) + perm32(R & 31)) : R;
        voffA[i] = (unsigned)(R * K + C) * 2u; voffB[i] = (unsigned)(Rb * K + C) * 2u; }
    const size_t kstep = (size_t)(BK * 2);
    const size_t hstep = (size_t)HALF * K * 2;
    const size_t tstep = 2 * hstep;
    const unsigned ldsw = (unsigned)wid * 1024u;
    const int aoff = lds_byte(wr * 64 + fr, fq * 8), boff = lds_byte(wc * 32 + fr, fq * 8);
#define PG8_SA(b, h) (((b) * 2 + (h)) * HTB)
#define PG8_SB(b, h) ((4 + (b) * 2 + (h)) * HTB)
#define PG8_STAGE(bufoff, gbase, voff) do { _Pragma("unroll") for (int _i = 0; _i < 2; ++_i) \
        __builtin_amdgcn_global_load_lds((const unsigned*)((const char*)(gbase) + (voff)[_i]), (PG8_LAS unsigned*)(lds + (bufoff) + ldsw + _i * 8192), 16, 0, 0); } while (0)
#define PG8_LDA(dst, b, h) do { _Pragma("unroll") for (int m = 0; m < 4; ++m) _Pragma("unroll") for (int k = 0; k < 2; ++k) dst[m][k] = *(const PG8_LAS bf16x8*)(lds + PG8_SA(b, h) + aoff + m * 2048 + k * 1024); } while (0)
#define PG8_LDB(dst, b, h) do { _Pragma("unroll") for (int n = 0; n < 2; ++n) _Pragma("unroll") for (int k = 0; k < 2; ++k) dst[n][k] = *(const PG8_LAS bf16x8*)(lds + PG8_SB(b, h) + boff + n * 2048 + k * 1024); } while (0)
#define PG8_MMA(ai, bj, At, Bt) do { __builtin_amdgcn_s_setprio(1); _Pragma("unroll") for (int m = 0; m < 4; ++m) _Pragma("unroll") for (int n = 0; n < 2; ++n) _Pragma("unroll") for (int k = 0; k < 2; ++k) \
        acc[ai][bj][m][n] = __builtin_amdgcn_mfma_f32_16x16x32_bf16(Bt[n][k], At[m][k], acc[ai][bj][m][n], 0, 0, 0); __builtin_amdgcn_s_setprio(0); } while (0)
#define PG8_WAIT_V(n) asm volatile("s_waitcnt vmcnt(" #n ")" ::: "memory")
#define PG8_WAIT_L(n) asm volatile("s_waitcnt lgkmcnt(" #n ")" ::: "memory")
#define PG8_BAR __builtin_amdgcn_s_barrier()
#define PG8_SCHED __builtin_amdgcn_sched_barrier(0)
    Unit cur, nxt; int ui = 0;
    if (!S.next(0, cur)) return;
    f32x4 acc[2][2][4][2];
#pragma unroll
    for (int a = 0; a < 2; ++a)
#pragma unroll
        for (int b = 0; b < 2; ++b)
#pragma unroll
            for (int m = 0; m < 4; ++m)
#pragma unroll
                for (int n = 0; n < 2; ++n) acc[a][b][m][n] = (f32x4){0.f, 0.f, 0.f, 0.f};
    bf16x8 At[4][2], B0[2][2], B1[2][2];
    const char* cA = (const char*)g.A + (size_t)cur.pm * tstep; const char* cB = (const char*)g.Bt + (size_t)cur.pn * tstep;
    S.a_ready(cur);
    if constexpr (SP2) {
        PG8_STAGE(PG8_SB(0, 0), cB, voffB); PG8_STAGE(PG8_SB(0, 1), cB + hstep, voffB); PG8_STAGE(PG8_SA(0, 0), cA, voffA); PG8_STAGE(PG8_SA(0, 1), cA + hstep, voffA);
        if (wr == 1) PG8_BAR;
        PG8_WAIT_V(2); PG8_BAR;
        PG8_STAGE(PG8_SB(1, 0), cB + kstep, voffB); PG8_STAGE(PG8_SA(1, 0), cA + kstep, voffA); PG8_STAGE(PG8_SB(1, 1), cB + hstep + kstep, voffB);
        PG8_WAIT_V(6); PG8_BAR;
    } else {
        PG8_STAGE(PG8_SB(0, 0), cB, voffB); PG8_STAGE(PG8_SA(0, 0), cA, voffA); PG8_STAGE(PG8_SB(0, 1), cB + hstep, voffB); PG8_STAGE(PG8_SA(0, 1), cA + hstep, voffA);
        if (wr == 1) PG8_BAR;
        PG8_WAIT_V(4); PG8_BAR;
        PG8_STAGE(PG8_SB(1, 0), cB + kstep, voffB); PG8_STAGE(PG8_SA(1, 0), cA + kstep, voffA); PG8_STAGE(PG8_SB(1, 1), cB + hstep + kstep, voffB);
        PG8_WAIT_V(6); PG8_BAR;
    }
    for (;;) {
        const bool has_next = S.next(ui + 1, nxt);
        const char* nA = has_next ? (const char*)g.A + (size_t)nxt.pm * tstep : cA; const char* nB = has_next ? (const char*)g.Bt + (size_t)nxt.pn * tstep : cB;
        for (int t = 0; t < nt; t += 2) {
            const bool last = (t == nt - 2);
            const char* a1 = cA + (size_t)(t + 1) * kstep;
            const char* a2 = last ? nA : cA + (size_t)(t + 2) * kstep; const char* b2 = last ? nB : cB + (size_t)(t + 2) * kstep;
            const char* a3 = a2 + kstep; const char* b3 = b2 + kstep;
            if (last && has_next) S.a_ready(nxt);
            if constexpr (SP2) {
            PG8_LDB(B0, 0, 0); PG8_LDB(B1, 0, 1); PG8_SCHED; PG8_LDA(At, 0, 0); PG8_STAGE(PG8_SA(1, 1), a1 + hstep, voffA);
            PG8_WAIT_V(8); PG8_WAIT_L(0); PG8_BAR; PG8_MMA(0, 0, At, B0); PG8_MMA(0, 1, At, B1); PG8_BAR; PG8_SCHED;
            PG8_LDA(At, 0, 1); PG8_STAGE(PG8_SB(0, 0), b2, voffB); PG8_STAGE(PG8_SB(0, 1), b2 + hstep, voffB); PG8_STAGE(PG8_SA(0, 0), a2, voffA);
            PG8_WAIT_V(8); PG8_WAIT_L(0); PG8_BAR; PG8_MMA(1, 0, At, B0); PG8_MMA(1, 1, At, B1); PG8_BAR; PG8_SCHED;
            PG8_LDB(B0, 1, 0); PG8_LDB(B1, 1, 1); PG8_SCHED; PG8_LDA(At, 1, 0); PG8_STAGE(PG8_SA(0, 1), a2 + hstep, voffA);
            PG8_WAIT_V(8); PG8_WAIT_L(0); PG8_BAR; PG8_MMA(0, 0, At, B0); PG8_MMA(0, 1, At, B1); PG8_BAR; PG8_SCHED;
            PG8_LDA(At, 1, 1); PG8_STAGE(PG8_SB(1, 0), b3, voffB); PG8_STAGE(PG8_SB(1, 1), b3 + hstep, voffB); PG8_STAGE(PG8_SA(1, 0), a3, voffA);
            PG8_WAIT_V(8); PG8_WAIT_L(0); PG8_BAR; PG8_MMA(1, 0, At, B0); PG8_MMA(1, 1, At, B1); PG8_BAR; PG8_SCHED;
            } else {
            PG8_LDB(B0, 0, 0); PG8_SCHED; PG8_LDA(At, 0, 0); PG8_STAGE(PG8_SA(1, 1), a1 + hstep, voffA);
            PG8_WAIT_L(8); PG8_BAR; PG8_WAIT_L(0); PG8_MMA(0, 0, At, B0); PG8_BAR; PG8_SCHED;
            PG8_LDB(B1, 0, 1); PG8_STAGE(PG8_SB(0, 0), b2, voffB);
            PG8_BAR; PG8_WAIT_L(0); PG8_MMA(0, 1, At, B1); PG8_BAR;
            PG8_LDA(At, 0, 1); PG8_STAGE(PG8_SA(0, 0), a2, voffA);
            PG8_BAR; PG8_WAIT_L(0); PG8_MMA(1, 0, At, B0); PG8_BAR; PG8_SCHED;
            PG8_STAGE(PG8_SB(0, 1), b2 + hstep, voffB);
            PG8_WAIT_V(6); PG8_BAR; PG8_MMA(1, 1, At, B1); PG8_BAR;
            PG8_LDB(B0, 1, 0); PG8_SCHED; PG8_LDA(At, 1, 0); PG8_STAGE(PG8_SA(0, 1), a2 + hstep, voffA);
            PG8_WAIT_L(8); PG8_BAR; PG8_WAIT_L(0); PG8_MMA(0, 0, At, B0); PG8_BAR; PG8_SCHED;
            PG8_LDB(B1, 1, 1); PG8_STAGE(PG8_SB(1, 0), b3, voffB);
            PG8_BAR; PG8_WAIT_L(0); PG8_MMA(0, 1, At, B1); PG8_BAR;
            PG8_LDA(At, 1, 1); PG8_STAGE(PG8_SA(1, 0), a3, voffA);
            PG8_BAR; PG8_WAIT_L(0); PG8_MMA(1, 0, At, B0); PG8_BAR; PG8_SCHED;
            PG8_STAGE(PG8_SB(1, 1), b3 + hstep, voffB);
            PG8_WAIT_V(6); PG8_BAR; PG8_MMA(1, 1, At, B1); PG8_BAR;
            }
        }
        if constexpr (ALIGN_EPI) { if (wr == 0) PG8_BAR; }
        if constexpr (!Epi::AFTER_DRAIN) { E(acc, cur, wr, wc, fr, fq); S.done(cur); }
        if (!has_next) break;
#pragma unroll
        for (int a = 0; a < 2; ++a)
#pragma unroll
            for (int b = 0; b < 2; ++b)
#pragma unroll
                for (int m = 0; m < 4; ++m)
#pragma unroll
                    for (int n = 0; n < 2; ++n) acc[a][b][m][n] = (f32x4){0.f, 0.f, 0.f, 0.f};
        cur = nxt; cA = nA; cB = nB; ++ui;
        if constexpr (ALIGN_EPI) { if (wr == 1) PG8_BAR; }
    }
    PG8_WAIT_V(0);
    if constexpr (!ALIGN_EPI) { if (wr == 0) PG8_BAR; }
    PG8_BAR;
    if constexpr (Epi::AFTER_DRAIN) { E.fused(acc, cur, wr, wc, fr, fq, lds, wid, lane); S.done(cur); }
#undef PG8_SA
#undef PG8_SB
#undef PG8_STAGE
#undef PG8_LDA
#undef PG8_LDB
#undef PG8_MMA
#undef PG8_WAIT_V
#undef PG8_WAIT_L
#undef PG8_BAR
#undef PG8_SCHED
}
}
#define GAS __attribute__((address_space(1)))
#define LAS __attribute__((address_space(3)))
typedef unsigned short bf16;
typedef unsigned v4u __attribute__((ext_vector_type(4)));
typedef float f32x4 __attribute__((ext_vector_type(4)));
typedef short bf16x8 __attribute__((ext_vector_type(8)));
typedef GAS unsigned gu32;
typedef GAS unsigned long long gu64;
#define RLX_AGENT __ATOMIC_RELAXED, __HIP_MEMORY_SCOPE_AGENT
#define LDS_WAIT() asm volatile("s_waitcnt lgkmcnt(0)" ::: "memory")
#define VM_WAIT() asm volatile("s_waitcnt vmcnt(0)" ::: "memory")
__device__ __forceinline__ unsigned long long rt() { return __builtin_amdgcn_s_memrealtime(); }
__device__ __forceinline__ unsigned f2bf(float f) { unsigned u = __builtin_bit_cast(unsigned, f); return (u + 0x7fffu + ((u >> 16) & 1u)) >> 16; }
__device__ __forceinline__ unsigned pk2(float lo, float hi) { return f2bf(lo) | (f2bf(hi) << 16); }
#define XB_TMO      128
#define XB_XCNT(j)  (256  + 64 * (j))
#define XB_XSUB(j)  (1280 + 64 * (j))
#define XB_XGEN(j)  (2304 + 64 * (j))
#define XB_TOP      3328
#define XB_TOPGEN   3392
#define XCD_BAR_WORDS 3456
#define XB_SPIN_CAP (1u << 18)

__device__ __forceinline__ unsigned xb_ld(unsigned* p)              { return __hip_atomic_load(p, __ATOMIC_RELAXED, __HIP_MEMORY_SCOPE_AGENT); }
__device__ __forceinline__ unsigned xb_add(unsigned* p, unsigned v) { return __hip_atomic_fetch_add(p, v, __ATOMIC_RELAXED, __HIP_MEMORY_SCOPE_AGENT); }
__device__ __forceinline__ unsigned xb_xcc_id() { return (unsigned)__builtin_amdgcn_s_getreg((3 << 11) | 20) & 0xFu; }
#define XB_SPIN(cond, bar) do { unsigned _sp = 0; while (cond) { __builtin_amdgcn_s_sleep(1); \
    if ((++_sp & 255u) == 0u) { if (xb_ld(&(bar)[XB_TMO])) break; if (_sp > XB_SPIN_CAP) { atomicAdd(&(bar)[XB_TMO], 1u); break; } } } } while (0)

struct XcdBarrier {
    unsigned* bar; unsigned x;
    volatile LAS unsigned* st;
};

__device__ __forceinline__ XcdBarrier xcd_barrier_post(unsigned* bar, volatile LAS unsigned* st) {
    XcdBarrier b; b.bar = bar; b.x = xb_xcc_id(); b.st = st;
    if (threadIdx.x == 0) (void)xb_add(&bar[XB_XCNT(b.x)], 1u);
    return b;
}
__device__ __forceinline__ void xcd_barrier_complete(unsigned* bar, unsigned x, unsigned& nloc, unsigned& nx) {
    const unsigned G = gridDim.x * gridDim.y * gridDim.z;
    unsigned sum, cnt, mine, sp = 0u;
    for (;;) {
        sum = 0u; cnt = 0u; mine = 0u;
#pragma unroll
        for (unsigned j = 0; j < 16; ++j) { const unsigned c = xb_ld(&bar[XB_XCNT(j)]); sum += c; cnt += (c > 0u) ? 1u : 0u; mine = (j == x) ? c : mine; }
        if (sum == G) break;
        __builtin_amdgcn_s_sleep(1);
        if ((++sp & 255u) == 0u) { if (xb_ld(&bar[XB_TMO])) break; if (sp > XB_SPIN_CAP) { atomicAdd(&bar[XB_TMO], 1u); break; } }
    }
    nloc = mine > 0u ? mine : 1u; nx = cnt > 0u ? cnt : 1u;
}

__device__ __forceinline__ void xcd_barrier(const XcdBarrier& b) {
    asm volatile("s_waitcnt vmcnt(0)" ::: "memory");
    __syncthreads();
    if (threadIdx.x == 0) {
        unsigned* bar = b.bar;
        __builtin_amdgcn_s_waitcnt(0);
        unsigned nloc = b.st[0], nx = b.st[1];
        if (nloc == 0u) { xcd_barrier_complete(bar, b.x, nloc, nx); b.st[0] = nloc; b.st[1] = nx; }
        const unsigned old = xb_add(&bar[XB_XSUB(b.x)], 1u);
        const unsigned gen = old / nloc;
        if (old + 1u == (gen + 1u) * nloc) {
            __builtin_amdgcn_fence(__ATOMIC_RELEASE, "agent");
            asm volatile("s_waitcnt vmcnt(0)" ::: "memory");
            const unsigned og = xb_add(&bar[XB_TOP], 1u);
            const unsigned tg = og / nx;
            if (og + 1u == (tg + 1u) * nx) xb_add(&bar[XB_TOPGEN], 1u);
            else XB_SPIN(xb_ld(&bar[XB_TOPGEN]) == tg, bar);
            __builtin_amdgcn_fence(__ATOMIC_ACQUIRE, "agent");
            xb_add(&bar[XB_XGEN(b.x)], 1u);
            asm volatile("s_waitcnt vmcnt(0)" ::: "memory");
        } else {
            XB_SPIN(xb_ld(&bar[XB_XGEN(b.x)]) == gen, bar);
            __builtin_amdgcn_fence(__ATOMIC_ACQUIRE, "agent");
            asm volatile("s_waitcnt vmcnt(0)" ::: "memory");
        }
    }
    __syncthreads();
}
constexpr int NWAVES = 8;
constexpr int BATCH = 8, SEQ = 2048, DM = 2048, M = BATCH * SEQ;
constexpr int IN_DIM = 5120, FF = 5632, PLE = 256, NH = 4, GW = 1024;
constexpr float EPS = 1e-6f, LOG2E = 1.4426950408889634f;
constexpr float QSCALE = 0.08838834764831845f * LOG2E;
typedef unsigned short bf16_t;
typedef unsigned u32x2 __attribute__((ext_vector_type(2)));
typedef unsigned u32x4v __attribute__((ext_vector_type(4)));
typedef short v4i16_t __attribute__((ext_vector_type(4)));
typedef LAS unsigned char* lptr;

constexpr size_t MiB = 1u << 20;
constexpr size_t WS_CTL = 0, CTL_ZERO_BYTES = 2 * MiB;
constexpr size_t WS_LNSTAT = 1 * MiB, WS_SS1 = 1 * MiB + 128 * 1024, WS_SS3 = 1 * MiB + 192 * 1024;
constexpr size_t WS_WIN = 2 * MiB, WS_WOUT = 22 * MiB, WS_W13 = 30 * MiB, WS_W2 = 74 * MiB, WS_WG = 96 * MiB, WS_WUP = 104 * MiB, WS_WSM = 105 * MiB;
constexpr size_t WS_PB = 106 * MiB;
constexpr size_t WS_UP = 114 * MiB;
constexpr size_t WS_A0 = 178 * MiB;
constexpr size_t WS_QKVUG = 242 * MiB;
constexpr size_t WS_H1B = 242 * MiB;
constexpr size_t WS_HID = 306 * MiB;
constexpr size_t WS_END = 482 * MiB;
constexpr int CW_BAR = 4096;

constexpr int RING_OFF = 0, RING_BYTES = 131072;
constexpr int LDSCTL_OFF = RING_BYTES, MISC_OFF = LDSCTL_OFF + 320;
constexpr int LDS_BYTES = 147456;

__device__ __forceinline__ float wave_sum(float v) {
#pragma unroll
    for (int o = 1; o < 64; o <<= 1) v += __shfl_xor(v, o);
    return v;
}
__device__ __forceinline__ float bf_lo(unsigned w) { return __uint_as_float(w << 16); }
__device__ __forceinline__ float bf_hi(unsigned w) { return __uint_as_float(w & 0xffff0000u); }

template <int MODE>
__device__ __forceinline__ void p0_transpose_item(const float* W, int K, int N, bf16_t* WT, int row_off, const float* kscale, LAS float* scr, int item, int lane) {
    const int nblk = N / 32, kb = item / nblk, nb = item % nblk, k0 = 64 * kb, n0 = 32 * nb;
#pragma unroll 8
    for (int i = 0; i < 32; ++i) { const int kk = 2 * i + (lane >> 5); float v = W[(size_t)(k0 + kk) * N + n0 + (lane & 31)]; if (kscale) v *= kscale[k0 + kk]; scr[kk * 33 + (lane & 31)] = v; }
    LDS_WAIT(); asm volatile("" ::: "memory");
    const int c = lane & 7;
#pragma unroll
    for (int j = 0; j < 4; ++j) { const int n = (lane >> 3) + 8 * j; const LAS float* s = scr + (8 * c) * 33 + n;
        v4u o; o.x = pk2(s[0 * 33], s[1 * 33]); o.y = pk2(s[2 * 33], s[3 * 33]); o.z = pk2(s[4 * 33], s[5 * 33]); o.w = pk2(s[6 * 33], s[7 * 33]);
        const int nn = n0 + n; const int row = (MODE == 0) ? nn : (256 * (nn >> 7) + (nn & 127) + row_off);
        *(GAS v4u*)(WT + (size_t)row * K + k0 + 8 * c) = o; }
    LDS_WAIT(); asm volatile("" ::: "memory");
}
struct P0Args { const float *x, *p, *w_in, *w_out, *g_attn, *g_ffn, *gmlp_ws, *w1, *w3, *w2, *w_up, *w_gate; unsigned char* ws; };
__device__ __forceinline__ void p0_prologue(const P0Args& A, lptr lds, int vcu, int G, int wave, int lane) {
    LAS float* scr = (LAS float*)(lds + RING_OFF + wave * 16384);
    const int gw = vcu * NWAVES + wave, NGW = G * NWAVES;
    bf16_t* Win_t = (bf16_t*)(A.ws + WS_WIN); bf16_t* Wout_t = (bf16_t*)(A.ws + WS_WOUT); bf16_t* W13_t = (bf16_t*)(A.ws + WS_W13); bf16_t* W2_t = (bf16_t*)(A.ws + WS_W2);
    bf16_t* Wg_t = (bf16_t*)(A.ws + WS_WG); bf16_t* Wup_t = (bf16_t*)(A.ws + WS_WUP); bf16_t* Wsm = (bf16_t*)(A.ws + WS_WSM);
    constexpr int I_IN = (DM / 64) * (IN_DIM / 32), I_OUT = (DM / 64) * (DM / 32), I_13 = (DM / 64) * (FF / 32), I_2 = (FF / 64) * (DM / 32), I_G = I_OUT, I_UP = (PLE / 64) * (DM / 32);
    constexpr int NITEMS = I_IN + I_OUT + 2 * I_13 + I_2 + I_G + I_UP;
    for (int it = gw; it < NITEMS; it += NGW) {
        int r = it;
        if (r < I_IN) { p0_transpose_item<0>(A.w_in, DM, IN_DIM, Win_t, 0, nullptr, scr, r, lane); continue; } r -= I_IN;
        if (r < I_OUT) { p0_transpose_item<0>(A.w_out, DM, DM, Wout_t, 0, nullptr, scr, r, lane); continue; } r -= I_OUT;
        if (r < I_13) { p0_transpose_item<1>(A.w1, DM, FF, W13_t, 0, A.g_ffn, scr, r, lane); continue; } r -= I_13;
        if (r < I_13) { p0_transpose_item<1>(A.w3, DM, FF, W13_t, 128, A.g_ffn, scr, r, lane); continue; } r -= I_13;
        if (r < I_2) { p0_transpose_item<0>(A.w2, FF, DM, W2_t, 0, nullptr, scr, r, lane); continue; } r -= I_2;
        if (r < I_G) { p0_transpose_item<0>(A.w_gate, DM, DM, Wg_t, 0, nullptr, scr, r, lane); continue; } r -= I_G;
        p0_transpose_item<0>(A.w_up, PLE, DM, Wup_t, 0, nullptr, scr, r, lane);
    }
    bf16_t* A0 = (bf16_t*)(A.ws + WS_A0);
    for (int m = gw; m < M; m += NGW) {
        const GAS f32x4* xr = (const GAS f32x4*)(A.x + (size_t)m * DM) + lane;
        f32x4 v[8]; float s = 0.f;
#pragma unroll
        for (int j = 0; j < 8; ++j) { v[j] = xr[64 * j]; s += (v[j].x * v[j].x + v[j].y * v[j].y) + (v[j].z * v[j].z + v[j].w * v[j].w); }
        const float r = 1.0f / sqrtf(wave_sum(s) * (1.0f / DM) + EPS);
        GAS unsigned long long* o8 = (GAS unsigned long long*)(A0 + (size_t)m * DM) + lane;
#pragma unroll
        for (int j = 0; j < 8; ++j) { const f32x4 g = *((const GAS f32x4*)A.g_attn + lane + 64 * j);
            o8[64 * j] = (unsigned long long)pk2(v[j].x * r * g.x, v[j].y * r * g.y) | ((unsigned long long)pk2(v[j].z * r * g.z, v[j].w * r * g.w) << 32); }
    }
    { bf16_t* PB = (bf16_t*)(A.ws + WS_PB); const int gt = gw * 64 + lane, NT = NGW * 64;
      for (int i = gt; i < M * PLE / 4; i += NT) { const f32x4 v = *((const GAS f32x4*)A.p + i);
          *((GAS unsigned long long*)PB + i) = (unsigned long long)pk2(v.x, v.y) | ((unsigned long long)pk2(v.z, v.w) << 32); } }
    { const int gt = gw * 64 + lane, NT = NGW * 64;
      for (int i = gt; i < 8 * 128 * 128 / 4; i += NT) { const f32x4 v = *((const GAS f32x4*)A.gmlp_ws + i); const int e = 4 * i, jj = e & 127, ii = (e >> 7) & 127;
          const bool keep = (jj >> 6) <= (ii >> 6);
          *((GAS unsigned long long*)Wsm + i) = keep ? ((unsigned long long)pk2(v.x, v.y) | ((unsigned long long)pk2(v.z, v.w) << 32)) : 0ull; } }
}

namespace att {
constexpr int KP = 272, VP = 544;
constexpr int L_K0 = 0, L_K1 = 64 * KP, L_V = 2 * 64 * KP, L_TAB = L_V + 64 * VP, L_END = L_TAB + 320 * 4;
constexpr int L_X = 0;
static_assert(65536 <= L_TAB && L_END <= RING_BYTES, "attention LDS map");
__device__ __forceinline__ pg8::bf16x8 mk8(v4i16_t lo, v4i16_t hi) { return (pg8::bf16x8){lo[0], lo[1], lo[2], lo[3], hi[0], hi[1], hi[2], hi[3]}; }
__device__ __forceinline__ v4i16_t vtr(lptr p) { return __builtin_amdgcn_ds_read_tr16_b64_v4i16((LAS v4i16_t*)p); }

__device__ __forceinline__ void attn_unit(lptr lds, const bf16_t* Q, const bf16_t* K, const bf16_t* V, bf16_t* MIX, const float* relb, const float* subg, float lam, int b, int h, int c) {
    const int tid = threadIdx.x, lane = tid & 63, w = __builtin_amdgcn_readfirstlane(tid >> 6), m = w >> 2, rg = w & 3, ql = lane & 15, fq = lane >> 4;
    const size_t tok0 = (size_t)b * SEQ + 64 * c;
    __syncthreads();
    if (tid < 320) {
        const int rel = tid - 255, n = rel < 0 ? -rel : rel;
        int bk;
        if (n < 8) bk = n; else { int lg = 8 + (int)(logf((float)n / 8.0f) / 2.7725887f * 8.0f); bk = lg < 15 ? lg : 15; }
        bk += (rel > 0) ? 16 : 0;
        ((LAS float*)(lds + L_TAB))[tid] = relb[bk * NH + h] * LOG2E;
    }
    const float cb = relb[15 * NH + h] * LOG2E;
    pg8::bf16x8 qf[4];
    { const bf16_t* qp = Q + (tok0 + 16 * rg + ql) * 1024 + h * 256 + m * 128 + 8 * fq;
#pragma unroll
      for (int ds = 0; ds < 4; ++ds) qf[ds] = *(const pg8::bf16x8*)(qp + 32 * ds); }
    f32x4 o[16];
#pragma unroll
    for (int i = 0; i < 16; ++i) o[i] = (f32x4){0.f, 0.f, 0.f, 0.f};
    float mrun = -1e30f, lsum = 0.f;
    const int krow = tid >> 4, kcc = tid & 15, vrow = tid >> 5, vcc = tid & 31;
    const bf16_t* kg = K + ((size_t)b * SEQ + krow) * 1024 + h * 256 + kcc * 8;
    const bf16_t* vg = V + ((size_t)b * SEQ + vrow) * 1024 + h * 256 + vcc * 8;
    v4u st[8];
#define ATT_ISSUE(t) do { const size_t ko = (size_t)(t) * 64 * 1024; \
        st[0] = *(const v4u*)(kg + ko); st[1] = *(const v4u*)(kg + ko + 32 * 1024); st[2] = *(const v4u*)(kg + ko + 128); st[3] = *(const v4u*)(kg + ko + 32 * 1024 + 128); \
        st[4] = *(const v4u*)(vg + ko); st[5] = *(const v4u*)(vg + ko + 16 * 1024); st[6] = *(const v4u*)(vg + ko + 32 * 1024); st[7] = *(const v4u*)(vg + ko + 48 * 1024); } while (0)
#define ATT_WRITE() do { \
        *(LAS v4u*)(lds + L_K0 + krow * KP + kcc * 16) = st[0]; *(LAS v4u*)(lds + L_K0 + (krow + 32) * KP + kcc * 16) = st[1]; \
        *(LAS v4u*)(lds + L_K1 + krow * KP + kcc * 16) = st[2]; *(LAS v4u*)(lds + L_K1 + (krow + 32) * KP + kcc * 16) = st[3]; \
        *(LAS v4u*)(lds + L_V + vrow * VP + vcc * 16) = st[4]; *(LAS v4u*)(lds + L_V + (vrow + 16) * VP + vcc * 16) = st[5]; \
        *(LAS v4u*)(lds + L_V + (vrow + 32) * VP + vcc * 16) = st[6]; *(LAS v4u*)(lds + L_V + (vrow + 48) * VP + vcc * 16) = st[7]; } while (0)
    const lptr kbase = lds + (m ? L_K1 : L_K0) + ql * KP + fq * 16;
    const lptr vbase = lds + L_V + (4 * fq + (ql >> 2)) * VP + (ql & 3) * 8;
    ATT_ISSUE(0);
    for (int t = 0; t <= c; ++t) {
        if (t > 0) __syncthreads();
        ATT_WRITE();
        __syncthreads();
        if (t < c) ATT_ISSUE(t + 1);
        const bool nearb = (t >= c - 3);
        f32x4 s[4];
#pragma unroll
        for (int kb = 0; kb < 4; ++kb) {
            const float ini = nearb ? 0.f : cb; f32x4 a = (f32x4){ini, ini, ini, ini};
#pragma unroll
            for (int ds = 0; ds < 4; ++ds) { const pg8::bf16x8 kf = *(const LAS pg8::bf16x8*)(kbase + kb * 16 * KP + ds * 64); a = __builtin_amdgcn_mfma_f32_16x16x32_bf16(kf, qf[ds], a, 0, 0, 0); }
            s[kb] = a;
        }
        if (nearb) {
            const int ib = 64 * (t - c) + 4 * fq - 16 * rg - ql + 255;
            const LAS float* tb = (const LAS float*)(lds + L_TAB) + ib;
#pragma unroll
            for (int kb = 0; kb < 4; ++kb)
#pragma unroll
                for (int r = 0; r < 4; ++r) s[kb][r] += tb[16 * kb + r];
        }
        float tmax = fmaxf(fmaxf(fmaxf(s[0][0], s[0][1]), fmaxf(s[0][2], s[0][3])), fmaxf(fmaxf(s[1][0], s[1][1]), fmaxf(s[1][2], s[1][3])));
        tmax = fmaxf(tmax, fmaxf(fmaxf(fmaxf(s[2][0], s[2][1]), fmaxf(s[2][2], s[2][3])), fmaxf(fmaxf(s[3][0], s[3][1]), fmaxf(s[3][2], s[3][3]))));
        tmax = fmaxf(tmax, __shfl_xor(tmax, 16)); tmax = fmaxf(tmax, __shfl_xor(tmax, 32));
        const float mnew = fmaxf(mrun, tmax);
        if (__any(mnew > mrun)) {
            const float alpha = __builtin_amdgcn_exp2f(mrun - mnew);
            lsum *= alpha;
#pragma unroll
            for (int i = 0; i < 16; ++i) o[i] = o[i] * alpha;
            mrun = mnew;
        }
        float ps = 0.f;
#pragma unroll
        for (int kb = 0; kb < 4; ++kb)
#pragma unroll
            for (int r = 0; r < 4; ++r) { s[kb][r] = __builtin_amdgcn_exp2f(s[kb][r] - mrun); ps += s[kb][r]; }
        lsum += ps;
        pg8::bf16x8 pa[2];
#pragma unroll
        for (int ks = 0; ks < 2; ++ks) { v4u pw; pw.x = pg8::cvt_pk_bf16(s[2 * ks][0], s[2 * ks][1]); pw.y = pg8::cvt_pk_bf16(s[2 * ks][2], s[2 * ks][3]);
            pw.z = pg8::cvt_pk_bf16(s[2 * ks + 1][0], s[2 * ks + 1][1]); pw.w = pg8::cvt_pk_bf16(s[2 * ks + 1][2], s[2 * ks + 1][3]); pa[ks] = __builtin_bit_cast(pg8::bf16x8, pw); }
#pragma unroll
        for (int ks = 0; ks < 2; ++ks)
#pragma unroll
            for (int blk = 0; blk < 16; ++blk) {
                const v4i16_t lo = vtr(vbase + ks * 32 * VP + blk * 32), hi = vtr(vbase + ks * 32 * VP + 16 * VP + blk * 32);
                o[blk] = __builtin_amdgcn_mfma_f32_16x16x32_bf16(mk8(lo, hi), pa[ks], o[blk], 0, 0, 0);
            }
    }
#undef ATT_ISSUE
#undef ATT_WRITE
    lsum += __shfl_xor(lsum, 16); lsum += __shfl_xor(lsum, 32);
    const float inv = 1.0f / lsum;
    __syncthreads();
    LAS f32x4* xo = (LAS f32x4*)(lds + L_X) + rg * 1024 + lane;
    if (m == 1) {
#pragma unroll
        for (int i = 0; i < 16; ++i) xo[i * 64] = o[i] * inv;
    }
    __syncthreads();
    if (m == 0) {
        float ss = 0.f;
#pragma unroll
        for (int i = 0; i < 16; ++i) { const f32x4 o2 = xo[i * 64]; o[i] = o[i] * inv - o2 * lam; ss += (o[i][0] * o[i][0] + o[i][1] * o[i][1]) + (o[i][2] * o[i][2] + o[i][3] * o[i][3]); }
        ss += __shfl_xor(ss, 16); ss += __shfl_xor(ss, 32);
        const float rn = (1.0f / sqrtf(ss * (1.0f / 256.0f) + EPS)) * 0.8f;
        bf16_t* op = MIX + (tok0 + 16 * rg + ql) * 2048 + h * 256 + 4 * fq;
#pragma unroll
        for (int i = 0; i < 16; ++i) { const f32x4 g = *(const f32x4*)(subg + 16 * i + 4 * fq); const f32x4 v = o[i] * rn * g;
            u32x2 wv; wv.x = pg8::cvt_pk_bf16(v[0], v[1]); wv.y = pg8::cvt_pk_bf16(v[2], v[3]); *(u32x2*)(op + 16 * i) = wv; }
    }
}
constexpr int GP = 288;
__device__ __forceinline__ void gmlp_unit(lptr lds, const bf16_t* U, const bf16_t* Gv, const float* lnstat, const float* lng, const float* lnb, const bf16_t* Wsm, const float* gb, bf16_t* MIX, int b, int n, int g) {
    const int tid = threadIdx.x, lane = tid & 63, w = __builtin_amdgcn_readfirstlane(tid >> 6), ql = lane & 15, fq = lane >> 4;
    const size_t tok0 = (size_t)b * SEQ + 128 * n;
    __syncthreads();
    { const int cc = tid & 15, r0 = tid >> 4;
      float gg[8], bb[8];
#pragma unroll
      for (int e = 0; e < 8; ++e) { gg[e] = lng[g * 128 + cc * 8 + e]; bb[e] = lnb[g * 128 + cc * 8 + e]; }
#pragma unroll
      for (int i = 0; i < 4; ++i) { const int row = r0 + 32 * i; const size_t tok = tok0 + row;
          const v4u raw = *(const v4u*)(Gv + tok * 1024 + g * 128 + cc * 8);
          const float s1 = lnstat[2 * tok], s2 = lnstat[2 * tok + 1]; const float mean = s1 * (1.0f / GW); const float var = s2 * (1.0f / GW) - mean * mean; const float rstd = 1.0f / sqrtf(var + EPS);
          float y[8]; y[0] = bf_lo(raw.x); y[1] = bf_hi(raw.x); y[2] = bf_lo(raw.y); y[3] = bf_hi(raw.y); y[4] = bf_lo(raw.z); y[5] = bf_hi(raw.z); y[6] = bf_lo(raw.w); y[7] = bf_hi(raw.w);
#pragma unroll
          for (int e = 0; e < 8; ++e) y[e] = (y[e] - mean) * rstd * gg[e] + bb[e];
          v4u ov; ov.x = pg8::cvt_pk_bf16(y[0], y[1]); ov.y = pg8::cvt_pk_bf16(y[2], y[3]); ov.z = pg8::cvt_pk_bf16(y[4], y[5]); ov.w = pg8::cvt_pk_bf16(y[6], y[7]);
          *(LAS v4u*)(lds + row * GP + cc * 16) = ov; } }
    __syncthreads();
    pg8::bf16x8 wf[4];
    { const bf16_t* wp = Wsm + ((size_t)g * 128 + 16 * w + ql) * 128 + 4 * fq;
#pragma unroll
      for (int s = 0; s < 4; ++s) { const u32x2 lo = *(const u32x2*)(wp + 32 * s), hi = *(const u32x2*)(wp + 32 * s + 16); v4u t4; t4.x = lo.x; t4.y = lo.y; t4.z = hi.x; t4.w = hi.y; wf[s] = __builtin_bit_cast(pg8::bf16x8, t4); } }
    f32x4 acc[8];
#pragma unroll
    for (int i = 0; i < 8; ++i) acc[i] = (f32x4){0.f, 0.f, 0.f, 0.f};
    const lptr vbase = lds + (4 * fq + (ql >> 2)) * GP + (ql & 3) * 8;
#pragma unroll
    for (int s = 0; s < 4; ++s)
#pragma unroll
        for (int blk = 0; blk < 8; ++blk) {
            const v4i16_t lo = vtr(vbase + s * 32 * GP + blk * 32), hi = vtr(vbase + s * 32 * GP + 16 * GP + blk * 32);
            acc[blk] = __builtin_amdgcn_mfma_f32_16x16x32_bf16(mk8(lo, hi), wf[s], acc[blk], 0, 0, 0);
        }
    const int irow = 16 * w + ql; const float bias = gb[g * 128 + irow]; const size_t tok = tok0 + irow;
    const bf16_t* up = U + tok * 1024 + g * 128 + 4 * fq; bf16_t* op = MIX + tok * 2048 + 1024 + g * 128 + 4 * fq;
#pragma unroll
    for (int blk = 0; blk < 8; ++blk) { const u32x2 uw = *(const u32x2*)(up + 16 * blk);
        const float o0 = bf_lo(uw.x) * (acc[blk][0] + bias), o1 = bf_hi(uw.x) * (acc[blk][1] + bias), o2 = bf_lo(uw.y) * (acc[blk][2] + bias), o3 = bf_hi(uw.y) * (acc[blk][3] + bias);
        u32x2 wv; wv.x = pg8::cvt_pk_bf16(o0, o1); wv.y = pg8::cvt_pk_bf16(o2, o3); *(u32x2*)(op + 16 * blk) = wv; }
}
}

__device__ __forceinline__ void p7_final(float* out, const float* ss3, const float* gfin, int vcu, int G, int wave, int lane) {
    const int gw = vcu * NWAVES + wave, NGW = G * NWAVES;
    f32x4 g[8];
#pragma unroll
    for (int j = 0; j < 8; ++j) g[j] = *((const GAS f32x4*)gfin + lane + 64 * j);
    for (int m = gw; m < M; m += NGW) {
        const float r = 1.0f / sqrtf(ss3[m] * (1.0f / DM) + EPS);
        GAS f32x4* xr = (GAS f32x4*)(out + (size_t)m * DM) + lane;
#pragma unroll
        for (int j = 0; j < 8; ++j) { f32x4 v = xr[64 * j]; v = v * r * g[j]; xr[64 * j] = v; }
    }
}
#ifndef PROBE_REP
#define PROBE_REP -1
#endif
#define REPS(k) for (int rep_ = (PROBE_REP == (k)) ? 0 : 1; rep_ < 2; ++rep_)
#ifndef MK_N_LAUNCHES
#define MK_N_LAUNCHES 1
#endif
constexpr int N_PHASES = 8;
struct Args { const float* in[22]; float* out; unsigned char* ws; int ph_lo, ph_hi, li, pad; };
__global__ void __launch_bounds__(NWAVES * 64, 2) mk_fwd(Args args) {
    extern __shared__ __attribute__((aligned(16))) unsigned char lds_raw[];
    const lptr lds = (lptr)lds_raw;
    volatile LAS unsigned* MISC = (volatile LAS unsigned*)(lds + MISC_OFF);
    const int tid = threadIdx.x, lane = tid & 63, wave = __builtin_amdgcn_readfirstlane(tid >> 6);
    const int G = gridDim.x; const int bx = blockIdx.x; const int vcu = (G % 8 == 0) ? (bx % 8) * (G / 8) + bx / 8 : bx;
    unsigned char* ws = args.ws;
    gu32* ctl = (gu32*)(ws + WS_CTL);
    for (int u = tid; u < (LDS_BYTES - LDSCTL_OFF) / 4; u += NWAVES * 64) ((LAS unsigned*)(lds + LDSCTL_OFF))[u] = 0u;
    __syncthreads();
    const int lo = args.ph_lo, hi = args.ph_hi;
    const bool use_bar = (hi - lo) > 1;
    XcdBarrier bar; bar.bar = (unsigned*)(ctl + CW_BAR); bar.x = 0; bar.st = nullptr;
    if (use_bar) bar = xcd_barrier_post((unsigned*)(ctl + CW_BAR), MISC + 8);
#define IN(k) (lo <= (k) && (k) < hi)
#define SEAM(k) do { if (IN(k) && IN((k) + 1)) xcd_barrier(bar); } while (0)

    bf16_t* Win_t = (bf16_t*)(ws + WS_WIN); bf16_t* Wout_t = (bf16_t*)(ws + WS_WOUT); bf16_t* W13_t = (bf16_t*)(ws + WS_W13); bf16_t* W2_t = (bf16_t*)(ws + WS_W2);
    bf16_t* Wg_t = (bf16_t*)(ws + WS_WG); bf16_t* Wup_t = (bf16_t*)(ws + WS_WUP); bf16_t* Wsm = (bf16_t*)(ws + WS_WSM);
    bf16_t* PB = (bf16_t*)(ws + WS_PB); bf16_t* UPB = (bf16_t*)(ws + WS_UP); bf16_t* A0 = (bf16_t*)(ws + WS_A0); bf16_t* MIX = (bf16_t*)(ws + WS_A0); bf16_t* H2B = (bf16_t*)(ws + WS_A0);
    bf16_t* QKVUG = (bf16_t*)(ws + WS_QKVUG); bf16_t* H1B = (bf16_t*)(ws + WS_H1B); bf16_t* HID = (bf16_t*)(ws + WS_HID);
    float* lnstat = (float*)(ws + WS_LNSTAT); float* ss1 = (float*)(ws + WS_SS1); float* ss3 = (float*)(ws + WS_SS3);

    if (IN(0)) {
        P0Args A{args.in[0], args.in[1], args.in[2], args.in[3], args.in[4], args.in[5], args.in[15], args.in[17], args.in[18], args.in[19], args.in[20], args.in[21], ws};
        p0_prologue(A, lds, vcu, G, wave, lane);
    }
    SEAM(0);
    if (IN(1)) {
        { pg8::Gemm g{A0, Win_t, M, IN_DIM, DM}; pg8::StaticOrder S; S.init(M, IN_DIM, G, bx);
          pg8::EpiIn E{QKVUG, lnstat, QSCALE};
          pg8::gemm_phase<pg8::EpiIn, pg8::StaticOrder, true, true>(lds + RING_OFF, g, S, E); }
        { pg8::Gemm g{PB, Wup_t, M, DM, PLE}; pg8::StaticOrder S; S.init(M, DM, G, bx);
          pg8::EpiPlain E{UPB, DM};
          pg8::gemm_phase<pg8::EpiPlain, pg8::StaticOrder, true, true>(lds + RING_OFF, g, S, E); }
    }
    SEAM(1);
    if (IN(2)) {
        const bf16_t* Qb = QKVUG; const bf16_t* Kb = QKVUG + (size_t)M * 1024; const bf16_t* Vb = QKVUG + (size_t)2 * M * 1024;
        const bf16_t* Ub = QKVUG + (size_t)3 * M * 1024; const bf16_t* Gb = QKVUG + (size_t)4 * M * 1024;
        float lam;
        { const float *q1 = args.in[7], *k1 = args.in[8], *q2 = args.in[9], *k2 = args.in[10];
          const float a = wave_sum(q1[lane] * k1[lane] + q1[lane + 64] * k1[lane + 64]), c2 = wave_sum(q2[lane] * k2[lane] + q2[lane + 64] * k2[lane + 64]);
          lam = expf(a) - expf(c2) + 0.2f; }
        for (int pi = vcu; pi < 512; pi += G) {
            const int bh = pi >> 4, s = pi & 15;
            att::attn_unit(lds, Qb, Kb, Vb, MIX, args.in[12], args.in[11], lam, bh >> 2, bh & 3, 31 - s);
            att::attn_unit(lds, Qb, Kb, Vb, MIX, args.in[12], args.in[11], lam, bh >> 2, bh & 3, s);
        }
        for (int ui = vcu; ui < 1024; ui += G)
            att::gmlp_unit(lds, Ub, Gb, lnstat, args.in[13], args.in[14], Wsm, args.in[16], MIX, ui >> 7, (ui >> 3) & 15, ui & 7);
        __syncthreads();
    }
    SEAM(2);
    if (IN(3)) {
        pg8::Gemm g{MIX, Wout_t, M, DM, DM}; pg8::StaticOrder S; S.init(M, DM, G, bx);
        pg8::EpiRes3 E{args.in[0], H1B, ss1, DM};
        pg8::gemm_phase<pg8::EpiRes3, pg8::StaticOrder, true, true>(lds + RING_OFF, g, S, E);
    }
    SEAM(3);
    if (IN(4)) {
        { pg8::Gemm g{H1B, W13_t, M, 2 * FF, DM}; pg8::StaticOrder S; S.init(M, 2 * FF, G, bx);
        pg8::EpiSwiGLU E{HID, ss1, FF};
        pg8::gemm_phase<pg8::EpiSwiGLU, pg8::StaticOrder, true, true>(lds + RING_OFF, g, S, E); }
    }
    SEAM(4);
    if (IN(5)) {
        pg8::Gemm g{HID, W2_t, M, DM, FF}; pg8::StaticOrder S; S.init(M, DM, G, bx);
        pg8::EpiRes5 E{H1B, H2B, DM};
        pg8::gemm_phase<pg8::EpiRes5, pg8::StaticOrder, true, true>(lds + RING_OFF, g, S, E);
    }
    SEAM(5);
    if (IN(6)) {
        pg8::Gemm g{H2B, Wg_t, M, DM, DM}; pg8::StaticOrder S; S.init(M, DM, G, bx);
        pg8::EpiGate E{H2B, args.out, UPB, ss3, DM};
        pg8::gemm_phase<pg8::EpiGate, pg8::StaticOrder, true, true>(lds + RING_OFF, g, S, E);
    }
    SEAM(6);
    if (IN(7)) p7_final(args.out, ss3, args.in[6], vcu, G, wave, lane);
#undef IN
#undef SEAM
}

extern "C" void kernel_launch(void* const* d_in, const int* in_sizes, int n_in, void* d_out, int out_size, void* d_ws, size_t ws_size, hipStream_t stream) {
    static int grid = 0;
    if (grid == 0) {
        if (n_in != 22 || in_sizes[0] != M * DM || out_size != M * DM || ws_size < WS_END) {
            fprintf(stderr, "kernel_launch: unexpected shapes (n_in %d, in0 %d, out %d, ws %zu); nothing launched\n", n_in, n_in > 0 ? in_sizes[0] : -1, out_size, ws_size); grid = -1; return; }
        int dev = 0, cus = 0, per_cu = 0;
        if (hipGetDevice(&dev) != hipSuccess || hipDeviceGetAttribute(&cus, hipDeviceAttributeMultiprocessorCount, dev) != hipSuccess) { grid = -1; return; }
        if (hipFuncSetAttribute((const void*)mk_fwd, hipFuncAttributeMaxDynamicSharedMemorySize, LDS_BYTES) != hipSuccess) { fprintf(stderr, "kernel_launch: hipFuncSetAttribute failed\n"); grid = -1; return; }
        if (hipOccupancyMaxActiveBlocksPerMultiprocessor(&per_cu, (const void*)mk_fwd, NWAVES * 64, LDS_BYTES) != hipSuccess || per_cu < 1) {
            fprintf(stderr, "kernel_launch: occupancy query reports %d workgroups per CU\n", per_cu); per_cu = 1; }
        (void)hipGetLastError();
        grid = cus;
    }
    if (grid < 0) return;
    if (hipMemsetAsync((char*)d_ws + WS_CTL, 0, CTL_ZERO_BYTES, stream) != hipSuccess) { fprintf(stderr, "kernel_launch: hipMemsetAsync failed\n"); return; }
    Args a{};
    for (int i = 0; i < 22; ++i) a.in[i] = (const float*)d_in[i];
    a.out = (float*)d_out; a.ws = (unsigned char*)d_ws;
    for (int li = 0; li < MK_N_LAUNCHES; ++li) {
        a.ph_lo = (MK_N_LAUNCHES == 1) ? 0 : li; a.ph_hi = (MK_N_LAUNCHES == 1) ? N_PHASES : li + 1; a.li = li;
#if MK_N_LAUNCHES == 1
        void* kargs[] = {(void*)&a};
        const hipError_t le = hipLaunchCooperativeKernel((const void*)mk_fwd, dim3(grid), dim3(NWAVES * 64), kargs, LDS_BYTES, stream);
#else
        hipLaunchKernelGGL(mk_fwd, dim3(grid), dim3(NWAVES * 64), LDS_BYTES, stream, a);
        const hipError_t le = hipPeekAtLastError();
#endif
        if (le != hipSuccess) { fprintf(stderr, "kernel_launch: launch %d failed: %s\n", li, hipGetErrorName(le)); break; }
    }
}
```
